# Optimizing an MI355X kernel written in HIP

```python
import math
import jax, jax.numpy as jnp
from jax import lax
import numpy as np

D_MODEL = 1024
BATCH = 4
SEQ = 4096
DEPTH = 2

MLA_HEADS = 4
MLA_NOPE = 128
MLA_ROPE = 64
MLA_VDIM = 128
MLA_Q_LORA = 256
MLA_KV_LORA = 256
MLA_WIDTH = MLA_HEADS * MLA_VDIM
ROPE_THETA = 10000.0
Q_BLOCK = 128

RWKV_HEADS = 4
RWKV_HEAD = 64
RWKV_WIDTH = RWKV_HEADS * RWKV_HEAD
RWKV_DECAY_LORA = 32
RWKV_AAA_LORA = 32
RWKV_GATE_LORA = 64
RWKV_LN_EPS = 64e-5

MLSTM_HEADS = 4
MLSTM_QK = 32
MLSTM_V = 64
MLSTM_WIDTH = MLSTM_HEADS * MLSTM_V
MLSTM_CHUNK = 64
MLSTM_CONV = 4

D_MIX = MLA_WIDTH + RWKV_WIDTH + MLSTM_WIDTH

D_FF = -(-8 * D_MODEL // (3 * 256)) * 256
NORM_EPS = 1e-6

MLA_SPLITS = (MLA_Q_LORA, MLA_KV_LORA, MLA_ROPE)
RWKV_SPLITS = (RWKV_WIDTH, RWKV_WIDTH, RWKV_WIDTH, RWKV_DECAY_LORA, RWKV_AAA_LORA, RWKV_GATE_LORA)
MLSTM_SPLITS = (MLSTM_HEADS * MLSTM_QK, MLSTM_HEADS * MLSTM_QK, MLSTM_WIDTH, MLSTM_HEADS, MLSTM_HEADS, MLSTM_WIDTH)
GROUP_SPLITS = (sum(MLA_SPLITS), sum(RWKV_SPLITS), sum(MLSTM_SPLITS))
P_IN = sum(GROUP_SPLITS)

kernel_name = "hybrid_mla_rwkv7_mlstm_block"


def _split(x, sizes):
    offs = np.cumsum(np.array(sizes))[:-1]
    return jnp.split(x, [int(o) for o in offs], axis=-1)


def _rmsnorm(x, g):
    xf = x.astype(jnp.float32)
    y = xf * lax.rsqrt(jnp.mean(xf * xf, axis=-1, keepdims=True) + NORM_EPS)
    return (y * g.astype(jnp.float32)).astype(x.dtype)


def _head_rmsnorm(x, g):
    B, S, H, dh = x.shape
    xf = x.astype(jnp.float32)
    y = xf * lax.rsqrt(jnp.mean(xf * xf, axis=-1, keepdims=True) + NORM_EPS)
    return y.reshape(B, S, H * dh) * g.astype(jnp.float32)


def _rope_tables(positions, dim):
    inv_freq = ROPE_THETA ** (-jnp.arange(0, dim, 2, dtype=jnp.float32) / dim)
    ang = positions.astype(jnp.float32)[..., None] * inv_freq
    return jnp.cos(ang), jnp.sin(ang)


def _rope(x, cos, sin):
    xf = x.astype(jnp.float32)
    x1, x2 = jnp.split(xf, 2, axis=-1)
    return jnp.concatenate([x1 * cos - x2 * sin, x1 * sin + x2 * cos], axis=-1).astype(x.dtype)


def _causal_conv(x, w, b):
    K = w.shape[0]
    S = x.shape[1]
    xp = jnp.pad(x, ((0, 0), (K - 1, 0), (0, 0)))
    out = b
    for j in range(K):
        out = out + xp[:, j:j + S] * w[j]
    return out


def _mla(c_q, c_kv, k_pe, positions, q_norm, w_uq, kv_norm, w_ukv, out_norm):
    B, S, _ = c_q.shape
    H = MLA_HEADS
    q = (_rmsnorm(c_q, q_norm) @ w_uq).reshape(B, S, H, MLA_NOPE + MLA_ROPE)
    q_nope, q_pe = q[..., :MLA_NOPE], q[..., MLA_NOPE:]
    kv = (_rmsnorm(c_kv, kv_norm) @ w_ukv).reshape(B, S, H, MLA_NOPE + MLA_VDIM)
    k_nope, v = kv[..., :MLA_NOPE], kv[..., MLA_NOPE:]
    cos, sin = _rope_tables(positions, MLA_ROPE)
    q_pe = _rope(q_pe, cos[:, :, None, :], sin[:, :, None, :])
    k_pe = _rope(k_pe, cos, sin)
    scale = (MLA_NOPE + MLA_ROPE) ** -0.5
    nb = S // Q_BLOCK
    qn_b = jnp.moveaxis(q_nope.reshape(B, nb, Q_BLOCK, H, MLA_NOPE), 1, 0)
    qp_b = jnp.moveaxis(q_pe.reshape(B, nb, Q_BLOCK, H, MLA_ROPE), 1, 0)
    key_pos = jnp.arange(S)

    def block(args):
        qn, qp, i = args
        s = (jnp.einsum('bqhd,bkhd->bhqk', qn, k_nope)
             + jnp.einsum('bqhr,bkr->bhqk', qp, k_pe)).astype(jnp.float32) * scale
        q_idx = i * Q_BLOCK + jnp.arange(Q_BLOCK)
        s = jnp.where(key_pos[None, :] <= q_idx[:, None], s, -jnp.inf)
        p = jax.nn.softmax(s, axis=-1).astype(v.dtype)
        return jnp.einsum('bhqk,bkhd->bqhd', p, v)

    o = lax.map(block, (qn_b, qp_b, jnp.arange(nb)))
    o = jnp.moveaxis(o, 0, 1).reshape(B, S, H, MLA_VDIM)
    return _head_rmsnorm(o, out_norm)


def _rwkv7(p, mu, w0, w2, a0, a2, g2, k_k, k_a, r_k, ln_w, ln_b):
    B, S, _ = p.shape
    H, N = RWKV_HEADS, RWKV_HEAD
    prev = jnp.pad(p, ((0, 0), (1, 0), (0, 0)))[:, :-1]
    p = p + (prev - p) * mu
    r, k, v, xw, xa, xg = _split(p, RWKV_SPLITS)
    w_log = -jax.nn.softplus(-(w0 + jnp.tanh(xw) @ w2).astype(jnp.float32)) - 0.5
    decay = jnp.exp(-jnp.exp(w_log))
    a = jax.nn.sigmoid((a0 + xa @ a2).astype(jnp.float32))
    g = jax.nn.sigmoid(xg) @ g2
    r = r.astype(jnp.float32).reshape(B, S, H, N)
    k = k.astype(jnp.float32)
    v = v.astype(jnp.float32).reshape(B, S, H, N)
    kk = (k * k_k.astype(jnp.float32)).reshape(B, S, H, N)
    kk = kk / jnp.maximum(jnp.sqrt(jnp.sum(kk * kk, axis=-1, keepdims=True)), 1e-12)
    k = (k * (1.0 + (a - 1.0) * k_a.astype(jnp.float32))).reshape(B, S, H, N)
    a = a.reshape(B, S, H, N)
    decay = decay.reshape(B, S, H, N)

    def step(state, inp):
        r_t, w_t, k_t, v_t, kk_t, a_t = inp
        sa = jnp.einsum('bhij,bhj->bhi', state, -kk_t)
        state = (state * w_t[:, :, None, :]
                 + sa[..., :, None] * (kk_t * a_t)[..., None, :]
                 + v_t[..., :, None] * k_t[..., None, :])
        return state, jnp.einsum('bhij,bhj->bhi', state, r_t)

    xs = tuple(jnp.moveaxis(t, 1, 0) for t in (r, decay, k, v, kk, a))
    _, y = lax.scan(step, jnp.zeros((B, H, N, N), jnp.float32), xs)
    y = jnp.moveaxis(y, 0, 1)
    mean = jnp.mean(y, axis=-1, keepdims=True)
    var = jnp.mean(jnp.square(y - mean), axis=-1, keepdims=True)
    y = ((y - mean) * lax.rsqrt(var + RWKV_LN_EPS)).reshape(B, S, RWKV_WIDTH)
    y = y * ln_w.astype(jnp.float32) + ln_b.astype(jnp.float32)
    bonus = jnp.sum(r * k * r_k.astype(jnp.float32).reshape(H, N), axis=-1, keepdims=True) * v
    y = y + bonus.reshape(B, S, RWKV_WIDTH)
    return y * g.astype(jnp.float32)


def _mlstm(p, conv_w, conv_b, i_bias, f_bias, out_norm):
    B, S, _ = p.shape
    H, DK, DV, L = MLSTM_HEADS, MLSTM_QK, MLSTM_V, MLSTM_CHUNK
    NC = S // L
    q, k, v, i_pre, f_pre, o_pre = _split(p, MLSTM_SPLITS)
    qk = jax.nn.silu(_causal_conv(jnp.concatenate([q, k], axis=-1), conv_w, conv_b))
    q, k = jnp.split(qk, 2, axis=-1)

    def heads(t, d):
        return t.astype(jnp.float32).reshape(B, NC, L, H, d).transpose(0, 3, 1, 2, 4)

    q = heads(q, DK) * DK ** -0.5
    k = heads(k, DK)
    v = heads(v, DV)
    log_i = (i_pre + i_bias).astype(jnp.float32).reshape(B, NC, L, H).transpose(0, 3, 1, 2)
    log_f = jax.nn.log_sigmoid((f_pre + f_bias).astype(jnp.float32)).reshape(B, NC, L, H).transpose(0, 3, 1, 2)
    g = jnp.cumsum(log_f, axis=-1)
    g_last = g[..., -1]
    a = g_last[..., None] - g + log_i

    def chunk_step(carry, inp):
        C, n, m = carry
        k_c, v_c, a_c, gl_c = inp
        m_new = jnp.maximum(gl_c + m, jnp.max(a_c, axis=-1))
        dec = jnp.exp(gl_c + m - m_new)
        wts = jnp.exp(a_c - m_new[..., None])
        C_new = dec[..., None, None] * C + jnp.einsum('bhl,bhld,bhle->bhde', wts, k_c, v_c)
        n_new = dec[..., None] * n + jnp.einsum('bhl,bhld->bhd', wts, k_c)
        return (C_new, n_new, m_new), (C, n, m)

    init = (jnp.zeros((B, H, DK, DV), jnp.float32), jnp.zeros((B, H, DK), jnp.float32),
            jnp.zeros((B, H), jnp.float32))
    xs = (jnp.moveaxis(k, 2, 0), jnp.moveaxis(v, 2, 0), jnp.moveaxis(a, 2, 0), jnp.moveaxis(g_last, 2, 0))
    _, (C_prev, n_prev, m_prev) = lax.scan(chunk_step, init, xs)
    C_prev = jnp.moveaxis(C_prev, 0, 2)
    n_prev = jnp.moveaxis(n_prev, 0, 2)
    m_prev = jnp.moveaxis(m_prev, 0, 2)

    causal = jnp.tril(jnp.ones((L, L), dtype=bool))
    D = jnp.where(causal, g[..., :, None] - g[..., None, :] + log_i[..., None, :], -jnp.inf)
    inter_log = g + m_prev[..., None]
    m_t = jnp.maximum(inter_log, jnp.max(D, axis=-1))
    inter_w = jnp.exp(inter_log - m_t)
    s = jnp.einsum('bhctd,bhcjd->bhctj', q, k) * jnp.exp(D - m_t[..., None])
    num = (inter_w[..., None] * jnp.einsum('bhctd,bhcde->bhcte', q, C_prev)
           + jnp.einsum('bhctj,bhcje->bhcte', s, v))
    den = inter_w * jnp.einsum('bhctd,bhcd->bhct', q, n_prev) + jnp.sum(s, axis=-1)
    den = jnp.maximum(jnp.abs(den), jnp.exp(-m_t))
    h = (num / den[..., None]).transpose(0, 2, 3, 1, 4).reshape(B, S, H, DV)
    return _head_rmsnorm(h, out_norm) * jax.nn.sigmoid(o_pre.astype(jnp.float32))


def setup_inputs(seed: int = 0) -> dict:
    key = jax.random.key(seed)
    ks = jax.random.split(key, 32)
    f32 = jnp.float32

    def nrm(k, shape, scale):
        return jax.random.normal(k, shape, f32) * scale

    def gain(k, shape):
        return 1.0 + 0.02 * jax.random.normal(k, shape, f32)

    offset = jax.random.randint(ks[1], (BATCH, 1), 0, 2048, dtype=jnp.int32)
    positions = offset + jnp.arange(SEQ, dtype=jnp.int32)[None, :]
    w0 = jnp.linspace(-6.0, -1.0, RWKV_WIDTH, dtype=f32) + 0.5
    f_b = jnp.linspace(3.0, 6.0, MLSTM_HEADS, dtype=f32)
    return {
        "x": nrm(ks[0], (BATCH, SEQ, D_MODEL), 1.0),
        "positions": positions,
        "mix_norm": gain(ks[2], (DEPTH, D_MODEL)),
        "w_in": nrm(ks[3], (DEPTH, D_MODEL, P_IN), D_MODEL ** -0.5),
        "mla_q_norm": gain(ks[4], (DEPTH, MLA_Q_LORA)),
        "mla_w_uq": nrm(ks[5], (DEPTH, MLA_Q_LORA, MLA_HEADS * (MLA_NOPE + MLA_ROPE)), MLA_Q_LORA ** -0.5),
        "mla_kv_norm": gain(ks[6], (DEPTH, MLA_KV_LORA)),
        "mla_w_ukv": nrm(ks[7], (DEPTH, MLA_KV_LORA, MLA_HEADS * (MLA_NOPE + MLA_VDIM)), MLA_KV_LORA ** -0.5),
        "mla_out_norm": gain(ks[8], (DEPTH, MLA_WIDTH)),
        "rwkv_mu": jax.random.uniform(ks[9], (DEPTH, GROUP_SPLITS[1]), f32),
        "rwkv_w0": w0[None, :] + nrm(ks[10], (DEPTH, RWKV_WIDTH), 0.1),
        "rwkv_w2": nrm(ks[11], (DEPTH, RWKV_DECAY_LORA, RWKV_WIDTH), 0.1 * RWKV_DECAY_LORA ** -0.5),
        "rwkv_a0": nrm(ks[12], (DEPTH, RWKV_WIDTH), 0.1),
        "rwkv_a2": nrm(ks[13], (DEPTH, RWKV_AAA_LORA, RWKV_WIDTH), RWKV_AAA_LORA ** -0.5),
        "rwkv_g2": nrm(ks[14], (DEPTH, RWKV_GATE_LORA, RWKV_WIDTH), RWKV_GATE_LORA ** -0.5),
        "rwkv_k_k": 0.85 + nrm(ks[15], (DEPTH, RWKV_WIDTH), 0.02),
        "rwkv_k_a": gain(ks[16], (DEPTH, RWKV_WIDTH)),
        "rwkv_r_k": nrm(ks[17], (DEPTH, RWKV_WIDTH), 0.1),
        "rwkv_ln_w": gain(ks[18], (DEPTH, RWKV_WIDTH)),
        "rwkv_ln_b": nrm(ks[19], (DEPTH, RWKV_WIDTH), 0.02),
        "mlstm_conv_w": nrm(ks[20], (DEPTH, MLSTM_CONV, 2 * MLSTM_HEADS * MLSTM_QK), MLSTM_CONV ** -0.5),
        "mlstm_conv_b": nrm(ks[21], (DEPTH, 2 * MLSTM_HEADS * MLSTM_QK), 0.02),
        "mlstm_i_bias": -1.0 + nrm(ks[22], (DEPTH, MLSTM_HEADS), 0.1),
        "mlstm_f_bias": f_b[None, :] + nrm(ks[23], (DEPTH, MLSTM_HEADS), 0.1),
        "mlstm_out_norm": gain(ks[24], (DEPTH, MLSTM_WIDTH)),
        "w_out": nrm(ks[25], (DEPTH, D_MIX, D_MODEL), D_MIX ** -0.5),
        "ffn_norm": gain(ks[26], (DEPTH, D_MODEL)),
        "w_gate": nrm(ks[27], (DEPTH, D_MODEL, D_FF), D_MODEL ** -0.5),
        "w_up": nrm(ks[28], (DEPTH, D_MODEL, D_FF), D_MODEL ** -0.5),
        "w_down": nrm(ks[29], (DEPTH, D_FF, D_MODEL), D_FF ** -0.5),
        "final_norm": gain(ks[30], (D_MODEL,)),
    }


def reference(x, positions, mix_norm, w_in, mla_q_norm, mla_w_uq, mla_kv_norm, mla_w_ukv, mla_out_norm,
              rwkv_mu, rwkv_w0, rwkv_w2, rwkv_a0, rwkv_a2, rwkv_g2, rwkv_k_k, rwkv_k_a, rwkv_r_k,
              rwkv_ln_w, rwkv_ln_b, mlstm_conv_w, mlstm_conv_b, mlstm_i_bias, mlstm_f_bias, mlstm_out_norm,
              w_out, ffn_norm, w_gate, w_up, w_down, final_norm):
    for l in range(DEPTH):
        h = _rmsnorm(x, mix_norm[l])
        p = h @ w_in[l]
        p_mla, p_rwkv, p_mlstm = _split(p, GROUP_SPLITS)
        c_q, c_kv, k_pe = _split(p_mla, MLA_SPLITS)
        y_mla = _mla(c_q, c_kv, k_pe, positions, mla_q_norm[l], mla_w_uq[l], mla_kv_norm[l],
                     mla_w_ukv[l], mla_out_norm[l])
        y_rwkv = _rwkv7(p_rwkv, rwkv_mu[l], rwkv_w0[l], rwkv_w2[l], rwkv_a0[l], rwkv_a2[l], rwkv_g2[l],
                        rwkv_k_k[l], rwkv_k_a[l], rwkv_r_k[l], rwkv_ln_w[l], rwkv_ln_b[l])
        y_mlstm = _mlstm(p_mlstm, mlstm_conv_w[l], mlstm_conv_b[l], mlstm_i_bias[l], mlstm_f_bias[l],
                         mlstm_out_norm[l])
        y = jnp.concatenate([y_mla.astype(x.dtype), y_rwkv.astype(x.dtype), y_mlstm.astype(x.dtype)], axis=-1)
        x = x + y @ w_out[l]
        h = _rmsnorm(x, ffn_norm[l])
        x = x + (jax.nn.silu(h @ w_gate[l]) * (h @ w_up[l])) @ w_down[l]
    return _rmsnorm(x, final_norm)
```

```cpp
#include <hip/hip_runtime.h>
#include <hip/hip_cooperative_groups.h>
#include <cstdint>
#include <cstdio>
namespace cg = cooperative_groups;

#ifndef PROBE_PH
#define PROBE_PH -1
#endif
#ifndef PROBE_VAR
#define PROBE_VAR 0
#endif
#ifndef PROBE_MODE
#define PROBE_MODE 0
#endif
#ifndef MK_ONE_LAUNCH
#define MK_ONE_LAUNCH 1
#endif

typedef unsigned short bf16_t;
typedef short bf16x8 __attribute__((ext_vector_type(8)));
typedef float f32x4 __attribute__((ext_vector_type(4)));
typedef float f32x2 __attribute__((ext_vector_type(2)));
typedef unsigned u32x4 __attribute__((ext_vector_type(4)));
typedef unsigned u32x2 __attribute__((ext_vector_type(2)));

constexpr int NB = 4, S = 4096, DM = 1024, T = NB * S;
constexpr int PIN = 2248, DFF = 2816;
constexpr int C_CQ = 0, C_CKV = 256, C_KPE = 512, C_RW = 576, C_ML = 1472;
constexpr int NTHREADS = 256;
constexpr int LDS_BYTES = 74240 + 64;

constexpr size_t OFF_CTRL = 0;
constexpr size_t OFF_BAR  = 4096;
constexpr size_t CTRL_BYTES = 32768;
constexpr size_t OFF_WIN  = CTRL_BYTES;
constexpr size_t OFF_WUQ  = OFF_WIN  + (size_t)2304 * 1024 * 2;
constexpr size_t OFF_WUKV = OFF_WUQ  + (size_t)768 * 256 * 2;
constexpr size_t OFF_WOUT = OFF_WUKV + (size_t)1024 * 256 * 2;
constexpr size_t OFF_P    = OFF_WOUT + (size_t)1024 * 1024 * 2;
constexpr size_t OFF_Q    = OFF_P    + (size_t)T * PIN * 2;
constexpr size_t OFF_KN   = OFF_Q    + (size_t)T * 768 * 2;
constexpr size_t OFF_KPE  = OFF_KN   + (size_t)T * 512 * 2;
constexpr size_t OFF_VT   = OFF_KPE  + (size_t)T * 64 * 2;
constexpr size_t OFF_RW   = OFF_VT   + (size_t)T * 512 * 2;
constexpr size_t OFF_RB   = OFF_RW   + (size_t)T * 256 * 4;
constexpr size_t OFF_RC   = OFF_RB   + (size_t)T * 4 * 320 * 2;
constexpr size_t OFF_Y    = OFF_RC   + (size_t)T * 4 * 4 * 4;
constexpr size_t OFF_MLC  = OFF_Y    + (size_t)T * 1024 * 2;
constexpr size_t OFF_MLN  = OFF_MLC  + (size_t)1024 * 2048 * 4;
constexpr size_t OFF_MLS  = OFF_MLN  + (size_t)1024 * 32 * 4;
constexpr size_t OFF_WGU  = OFF_MLS  + (size_t)1024 * 4 * 4;
constexpr size_t OFF_WDN  = OFF_WGU  + (size_t)5632 * 1024 * 2;
constexpr size_t OFF_WOUT2 = OFF_WDN + (size_t)1024 * 2816 * 2;
constexpr size_t OFF_Z    = OFF_WOUT2 + (size_t)1024 * 1024 * 2;
constexpr size_t OFF_SF   = OFF_Z    + (size_t)16 * 2048 * 64 * 2;
constexpr size_t OFF_RSS  = OFF_SF   + (size_t)16 * 64 * 64 * 4;
constexpr size_t WS_TOTAL = OFF_RSS  + (size_t)4 * T * 4;
constexpr size_t OFF_XB   = OFF_KN;
static_assert((size_t)T * DM * 2 <= (OFF_RW - OFF_KN), "XB overlay");
constexpr size_t OFF_U    = OFF_P;
static_assert((size_t)T * DFF * 2 <= (OFF_KN - OFF_P), "U overlay");
static_assert(WS_TOTAL <= ((size_t)256 << 20), "workspace");

struct Params {
  const float* x; const int* pos;
  const float *mix_norm, *w_in, *q_norm, *w_uq, *kv_norm, *w_ukv, *mla_out_norm;
  const float *mu, *w0, *w2, *a0, *a2, *g2, *k_k, *k_a, *r_k, *ln_w, *ln_b;
  const float *conv_w, *conv_b, *i_bias, *f_bias, *ml_out_norm;
  const float *w_out, *ffn_norm, *w_gate, *w_up, *w_down, *final_norm;
  float* out; unsigned char* ws;
  int phase_lo, phase_hi;
};

__device__ __forceinline__ unsigned char* WS(const Params& p) { unsigned z = 0; asm volatile("" : "+s"(z)); return p.ws + z; }
__device__ const float c_inv_freq[32] = {
1.000000000e+00f, 7.498942093e-01f, 5.623413252e-01f, 4.216965034e-01f, 3.162277660e-01f, 2.371373706e-01f, 1.778279410e-01f, 1.333521432e-01f, 1.000000000e-01f, 7.498942093e-02f, 5.623413252e-02f, 4.216965034e-02f, 3.162277660e-02f, 2.371373706e-02f, 1.778279410e-02f, 1.333521432e-02f, 1.000000000e-02f, 7.498942093e-03f, 5.623413252e-03f, 4.216965034e-03f, 3.162277660e-03f, 2.371373706e-03f, 1.778279410e-03f, 1.333521432e-03f, 1.000000000e-03f, 7.498942093e-04f, 5.623413252e-04f, 4.216965034e-04f, 3.162277660e-04f, 2.371373706e-04f, 1.778279410e-04f, 1.333521432e-04f};

__device__ __forceinline__ int opaque_tid() { int t = threadIdx.x; asm volatile("" : "+v"(t)); return t; }
__device__ __forceinline__ float bf2f(unsigned short b) { return __uint_as_float(((unsigned)b) << 16); }
__device__ __forceinline__ unsigned short f2bf(float f) { unsigned r; asm("v_cvt_pk_bf16_f32 %0, %1, %1" : "=v"(r) : "v"(f)); return (unsigned short)(r & 0xffffu); }
__device__ __forceinline__ unsigned pk2(float lo, float hi) { unsigned r; asm("v_cvt_pk_bf16_f32 %0, %1, %2" : "=v"(r) : "v"(lo), "v"(hi)); return r; }
__device__ __forceinline__ float bflo(unsigned u) { return __uint_as_float(u << 16); }
__device__ __forceinline__ float bfhi(unsigned u) { return __uint_as_float(u & 0xffff0000u); }
__device__ __forceinline__ float wave_sum(float v);
__device__ __forceinline__ float sigmoidf_(float x) { return __builtin_amdgcn_rcpf(1.0f + __expf(-x)); }
__device__ __forceinline__ float fma_s(float a, float b, float c) { float d; asm("v_fma_f32 %0, %1, %2, %3" : "=v"(d) : "v"(a), "v"(b), "v"(c)); return d; }
__device__ __forceinline__ float fnma_s(float a, float b, float c) { float d; asm("v_fma_f32 %0, -%1, %2, %3" : "=v"(d) : "v"(a), "v"(b), "v"(c)); return d; }
__device__ __forceinline__ float mul_s(float a, float b) { float d; asm("v_mul_f32 %0, %1, %2" : "=v"(d) : "v"(a), "v"(b)); return d; }
__device__ __forceinline__ float add_s(float a, float b) { float d; asm("v_add_f32 %0, %1, %2" : "=v"(d) : "v"(a), "v"(b)); return d; }
__device__ __forceinline__ float sel_eq(float keep, float v, int a, int b) { asm("v_cmp_eq_u32 vcc, %1, %2\n\tv_cndmask_b32 %0, %0, %3, vcc" : "+v"(keep) : "v"(a), "v"(b), "v"(v) : "vcc"); return keep; }
template <int CTRL> __device__ __forceinline__ float dppf(float v) {
  return __int_as_float(__builtin_amdgcn_update_dpp(0, __float_as_int(v), CTRL, 0xf, 0xf, true));
}
__device__ __forceinline__ float row16_sum(float x) {
  x += dppf<0xB1>(x); x += dppf<0x4E>(x); x += dppf<0x124>(x); x += dppf<0x128>(x);
  return x;
}
__device__ __forceinline__ float wave_sum(float v) {
  v = row16_sum(v); v += __shfl_xor(v, 16); v += __shfl_xor(v, 32);
  return v;
}
__device__ __forceinline__ void rope_cs(int pos, int i, float& c, float& s) {
  double rev = (double)pos * (double)c_inv_freq[i] * 0.15915494309189535;
  rev -= rint(rev);
  float r = (float)rev;
  s = __builtin_amdgcn_sinf(r); c = __builtin_amdgcn_cosf(r);
}


#define XB_TMO      128
#define XB_XCNT(j)  (256  + 64 * (j))
#define XB_XSUB(j)  (1280 + 64 * (j))
#define XB_XGEN(j)  (2304 + 64 * (j))
#define XB_TOP      3328
#define XB_TOPGEN   3392
#define XCD_BAR_WORDS 3456
#define XB_SPIN_CAP (1u << 20)
#define LAS __attribute__((address_space(3)))
__device__ __forceinline__ unsigned xb_ld(unsigned* p)              { return __hip_atomic_load(p, __ATOMIC_RELAXED, __HIP_MEMORY_SCOPE_AGENT); }
__device__ __forceinline__ unsigned xb_add(unsigned* p, unsigned v) { return __hip_atomic_fetch_add(p, v, __ATOMIC_RELAXED, __HIP_MEMORY_SCOPE_AGENT); }
__device__ __forceinline__ unsigned xb_xcc_id() { return (unsigned)__builtin_amdgcn_s_getreg((3 << 11) | 20) & 0xFu; }
#define XB_SPIN(cond, bar) do { unsigned _sp = 0; while (cond) { __builtin_amdgcn_s_sleep(1); \
    if ((++_sp & 255u) == 0u) { if (xb_ld(&(bar)[XB_TMO])) break; if (_sp > XB_SPIN_CAP) { atomicAdd(&(bar)[XB_TMO], 1u); break; } } } } while (0)
struct XcdBarrier { unsigned* bar; unsigned x; volatile LAS unsigned* st; };
__device__ __forceinline__ XcdBarrier xcd_barrier_post(unsigned* bar, volatile LAS unsigned* st) {
    XcdBarrier b; b.bar = bar; b.x = xb_xcc_id(); b.st = st;
    if (opaque_tid() == 0) (void)xb_add(&bar[XB_XCNT(b.x)], 1u);
    return b;
}
__device__ __forceinline__ void xcd_barrier_complete(unsigned* bar, unsigned x, unsigned& nloc, unsigned& nx) {
    const unsigned G = gridDim.x * gridDim.y * gridDim.z;
    unsigned sum, cnt, mine, sp = 0u;
    for (;;) {
        sum = 0u; cnt = 0u; mine = 0u;
#pragma unroll
        for (unsigned j = 0; j < 16; ++j) { const unsigned c = xb_ld(&bar[XB_XCNT(j)]); sum += c; cnt += (c > 0u) ? 1u : 0u; mine = (j == x) ? c : mine; }
        if (sum == G) break;
        __builtin_amdgcn_s_sleep(1);
        if ((++sp & 255u) == 0u) { if (xb_ld(&bar[XB_TMO])) break; if (sp > XB_SPIN_CAP) { atomicAdd(&bar[XB_TMO], 1u); break; } }
    }
    nloc = mine > 0u ? mine : 1u; nx = cnt > 0u ? cnt : 1u;
}
__device__ __forceinline__ void xcd_barrier(const XcdBarrier& b) {
    asm volatile("s_waitcnt vmcnt(0)" ::: "memory");
    __syncthreads();
    if (opaque_tid() == 0) {
        unsigned* bar = b.bar;
        __builtin_amdgcn_s_waitcnt(0);
        unsigned nloc = b.st[0], nx = b.st[1];
        if (nloc == 0u) { xcd_barrier_complete(bar, b.x, nloc, nx); b.st[0] = nloc; b.st[1] = nx; }
        const unsigned old = xb_add(&bar[XB_XSUB(b.x)], 1u);
        const unsigned gen = old / nloc;
        if (old + 1u == (gen + 1u) * nloc) {
            __builtin_amdgcn_fence(__ATOMIC_RELEASE, "agent");
            asm volatile("s_waitcnt vmcnt(0)" ::: "memory");
            const unsigned og = xb_add(&bar[XB_TOP], 1u);
            const unsigned tg = og / nx;
            if (og + 1u == (tg + 1u) * nx) xb_add(&bar[XB_TOPGEN], 1u);
            else XB_SPIN(xb_ld(&bar[XB_TOPGEN]) == tg, bar);
            __builtin_amdgcn_fence(__ATOMIC_ACQUIRE, "agent");
            xb_add(&bar[XB_XGEN(b.x)], 1u);
            asm volatile("s_waitcnt vmcnt(0)" ::: "memory");
        } else {
            XB_SPIN(xb_ld(&bar[XB_XGEN(b.x)]) == gen, bar);
            __builtin_amdgcn_fence(__ATOMIC_ACQUIRE, "agent");
            asm volatile("s_waitcnt vmcnt(0)" ::: "memory");
        }
    }
    __syncthreads();
}

__device__ __forceinline__ void conv_tile(const float* __restrict__ s0, const float* __restrict__ s1, int mode, int K, int Nsrc,
                          const float* __restrict__ gain, bf16_t* __restrict__ dst, int kt, int nt, char* ldsraw) {
  float* lds = (float*)ldsraw;
  const int tid = opaque_tid();
  const float* gp = gain ? gain : s0;
  float vals[16], gv[16];
#pragma unroll
  for (int i = 0; i < 16; i++) {
    const int idx = tid + 256 * i; const int kk = idx >> 6, nn = idx & 63; const int n = nt * 64 + nn, k = kt * 64 + kk;
    const float* sp; int col;
    if (mode == 0) { sp = s0; col = (n < Nsrc) ? n : (Nsrc - 1); }
    else { const int g = n >> 5, r = n & 31; col = g * 16 + (r & 15); sp = (r < 16) ? s0 : s1; }
    vals[i] = __builtin_nontemporal_load(sp + (size_t)k * Nsrc + col);
    gv[i] = gp[k];
  }
#pragma unroll
  for (int i = 0; i < 16; i++) {
    const int idx = tid + 256 * i; const int kk = idx >> 6, nn = idx & 63; const int n = nt * 64 + nn;
    float v = gain ? vals[i] * gv[i] : vals[i];
    if (mode == 0 && n >= Nsrc) v = 0.f;
    lds[kk * 65 + nn] = v;
  }
  __syncthreads();
#pragma unroll
  for (int i = 0; i < 2; i++) {
    const int idx = tid + 256 * i; const int nn = idx >> 3, ch = idx & 7;
    const float* lp = lds + (ch * 8) * 65 + nn;
    u32x4 w;
    w[0] = pk2(lp[0], lp[65]); w[1] = pk2(lp[2 * 65], lp[3 * 65]); w[2] = pk2(lp[4 * 65], lp[5 * 65]); w[3] = pk2(lp[6 * 65], lp[7 * 65]);
    *(u32x4*)(dst + (size_t)(nt * 64 + nn) * K + kt * 64 + ch * 8) = w;
  }
  __syncthreads();
}
constexpr int N_CONV_MIX = 576 + 48 + 64 + 256;
constexpr int N_CONV_FFN = 1408 + 704;
__device__ __forceinline__ void conv_mixer(const Params& p, int l, int item, char* lds) {
  unsigned char* ws = WS(p);
  if (item < 576) conv_tile(p.w_in + (size_t)l * 1024 * PIN, nullptr, 0, 1024, PIN, p.mix_norm + l * 1024, (bf16_t*)(ws + OFF_WIN), item / 36, item % 36, lds);
  else if (item < 624) { item -= 576; conv_tile(p.w_uq + (size_t)l * 256 * 768, nullptr, 0, 256, 768, p.q_norm + l * 256, (bf16_t*)(ws + OFF_WUQ), item / 12, item % 12, lds); }
  else if (item < 688) { item -= 624; conv_tile(p.w_ukv + (size_t)l * 256 * 1024, nullptr, 0, 256, 1024, p.kv_norm + l * 256, (bf16_t*)(ws + OFF_WUKV), item / 16, item % 16, lds); }
  else { item -= 688; conv_tile(p.w_out + (size_t)l * 1024 * 1024, nullptr, 0, 1024, 1024, nullptr, (bf16_t*)(ws + ((l & 1) ? OFF_WOUT2 : OFF_WOUT)), item / 16, item % 16, lds); }
}
__device__ __forceinline__ void conv_ffn(const Params& p, int l, int item, char* lds) {
  unsigned char* ws = WS(p);
  if (item < 1408) conv_tile(p.w_gate + (size_t)l * 1024 * DFF, p.w_up + (size_t)l * 1024 * DFF, 1, 1024, DFF, p.ffn_norm + l * 1024, (bf16_t*)(ws + OFF_WGU), item / 88, item % 88, lds);
  else { item -= 1408; conv_tile(p.w_down + (size_t)l * DFF * 1024, nullptr, 0, DFF, 1024, nullptr, (bf16_t*)(ws + OFF_WDN), item / 16, item % 16, lds); }
}

template <bool AF32, bool ROWSS>
__device__ __forceinline__ void gemm_mainloop(const void* __restrict__ Ap, int lda, const bf16_t* __restrict__ Bt, int K,
                                              int m0, int n0, f32x4 (&acc)[4][4], char* lds, float eps) {
  const int tid = opaque_tid(), lane = tid & 63, wid = tid >> 6, wr = wid >> 1, wc = wid & 1, fr = lane & 15, fq = lane >> 4;
  const int lr = tid >> 3, lc = tid & 7;
  u32x4 ra[4], rb[4]; f32x4 fa[4][2];
  float ss[4] = {0.f, 0.f, 0.f, 0.f};
#pragma unroll
  for (int m = 0; m < 4; m++)
#pragma unroll
    for (int n = 0; n < 4; n++) acc[m][n] = (f32x4){0.f, 0.f, 0.f, 0.f};
  const int nk = K >> 6;
  auto gload = [&](int kt) {
#pragma unroll
    for (int i = 0; i < 4; i++) {
      const int row = lr + 32 * i;
      if (AF32) { const float* q = (const float*)Ap + (size_t)(m0 + row) * lda + kt * 64 + lc * 8; fa[i][0] = *(const f32x4*)q; fa[i][1] = *(const f32x4*)(q + 4); }
      else { const bf16_t* q = (const bf16_t*)Ap + (size_t)(m0 + row) * lda + kt * 64 + lc * 8; ra[i] = *(const u32x4*)q; }
      rb[i] = *(const u32x4*)(Bt + (size_t)(n0 + row) * K + kt * 64 + lc * 8);
    }
  };
  auto lstore = [&](int st) {
    char* la = lds + st * 18432; char* lb = lds + 36864 + st * 18432;
#pragma unroll
    for (int i = 0; i < 4; i++) {
      const int row = lr + 32 * i;
      u32x4 w;
      if (AF32) {
        f32x4 a = fa[i][0], b = fa[i][1];
        if (ROWSS) ss[i] += a[0] * a[0] + a[1] * a[1] + a[2] * a[2] + a[3] * a[3] + b[0] * b[0] + b[1] * b[1] + b[2] * b[2] + b[3] * b[3];
        w[0] = pk2(a[0], a[1]); w[1] = pk2(a[2], a[3]); w[2] = pk2(b[0], b[1]); w[3] = pk2(b[2], b[3]);
      } else {
        w = ra[i];
        if (ROWSS) {
#pragma unroll
          for (int e = 0; e < 4; e++) { float lo = bflo(w[e]), hi = bfhi(w[e]); ss[i] += lo * lo + hi * hi; }
        }
      }
      *(u32x4*)(la + (row * 72 + lc * 8) * 2) = w;
      *(u32x4*)(lb + (row * 72 + lc * 8) * 2) = rb[i];
    }
  };
  gload(0); lstore(0); __syncthreads();
  for (int kt = 0; kt < nk; kt++) {
    const int st = kt & 1;
    if (kt + 1 < nk) gload(kt + 1);
    const char* la = lds + st * 18432; const char* lb = lds + 36864 + st * 18432;
    {
      bf16x8 af[2][4], bfv[2][4];
#pragma unroll
      for (int kc = 0; kc < 2; kc++) {
#pragma unroll
        for (int m = 0; m < 4; m++) af[kc][m] = *(const bf16x8*)(la + ((wr * 64 + m * 16 + fr) * 72 + kc * 32 + fq * 8) * 2);
#pragma unroll
        for (int n = 0; n < 4; n++) bfv[kc][n] = *(const bf16x8*)(lb + ((wc * 64 + n * 16 + fr) * 72 + kc * 32 + fq * 8) * 2);
      }
      __builtin_amdgcn_sched_barrier(0);
#pragma unroll
      for (int kc = 0; kc < 2; kc++)
#pragma unroll
        for (int m = 0; m < 4; m++)
#pragma unroll
          for (int n = 0; n < 4; n++) acc[m][n] = __builtin_amdgcn_mfma_f32_16x16x32_bf16(bfv[kc][n], af[kc][m], acc[m][n], 0, 0, 0);
      __builtin_amdgcn_sched_barrier(0);
    }
    if (kt + 1 < nk) lstore(st ^ 1);
    __syncthreads();
  }
  if (ROWSS) {
    float* rs = (float*)(lds + 73728);
#pragma unroll
    for (int i = 0; i < 4; i++) {
      float v = ss[i]; v += __shfl_xor(v, 1); v += __shfl_xor(v, 2); v += __shfl_xor(v, 4);
      if (lc == 0) rs[lr + 32 * i] = rsqrtf(v / (float)K + eps);
    }
    __syncthreads();
  }
}
template <bool ROWSS>
__device__ __forceinline__ void gemm_mainloop_b(const bf16_t* __restrict__ Ap, int lda, const bf16_t* __restrict__ Bt, int K,
                                                int m0, int n0, f32x4 (&acc)[4][4], char* lds, float eps) {
  const int tid = opaque_tid(), lane = tid & 63, wid = tid >> 6, wr = wid >> 1, wc = wid & 1, fr = lane & 15, fq = lane >> 4;
  const int lr = tid >> 3, lc = tid & 7;
  u32x4 ra0[4], rb0[4];
  float ss[4] = {0.f, 0.f, 0.f, 0.f};
#pragma unroll
  for (int m = 0; m < 4; m++)
#pragma unroll
    for (int n = 0; n < 4; n++) acc[m][n] = (f32x4){0.f, 0.f, 0.f, 0.f};
  const int nk = K >> 6;
  const bf16_t* pa = Ap + (size_t)(m0 + lr) * lda + lc * 8;
  const bf16_t* pb = Bt + (size_t)(n0 + lr) * K + lc * 8;
#define GL(ra_, rb_, kt_) { _Pragma("unroll") for (int i = 0; i < 4; i++) { ra_[i] = *(const u32x4*)(pa + (size_t)(32 * i) * lda + (kt_) * 64); rb_[i] = *(const u32x4*)(pb + (size_t)(32 * i) * K + (kt_) * 64); } }
#define LS(ra_, rb_, st_) { char* la_ = lds + (st_) * 18432; char* lb_ = lds + 36864 + (st_) * 18432; _Pragma("unroll") for (int i = 0; i < 4; i++) { const int row = lr + 32 * i; u32x4 w = ra_[i]; \
      if (ROWSS) { _Pragma("unroll") for (int e = 0; e < 4; e++) { float lo = bflo(w[e]), hi = bfhi(w[e]); ss[i] += lo * lo + hi * hi; } } \
      *(u32x4*)(la_ + (row * 72 + lc * 8) * 2) = w; *(u32x4*)(lb_ + (row * 72 + lc * 8) * 2) = rb_[i]; } }
#define CMP(st_) { const char* la_ = lds + (st_) * 18432; const char* lb_ = lds + 36864 + (st_) * 18432; bf16x8 af[2][4], bfv[2][4]; \
      _Pragma("unroll") for (int kc = 0; kc < 2; kc++) { \
      _Pragma("unroll") for (int m = 0; m < 4; m++) af[kc][m] = *(const bf16x8*)(la_ + ((wr * 64 + m * 16 + fr) * 72 + kc * 32 + fq * 8) * 2); \
      _Pragma("unroll") for (int n = 0; n < 4; n++) bfv[kc][n] = *(const bf16x8*)(lb_ + ((wc * 64 + n * 16 + fr) * 72 + kc * 32 + fq * 8) * 2); } \
      __builtin_amdgcn_sched_barrier(0); \
      _Pragma("unroll") for (int kc = 0; kc < 2; kc++) \
      _Pragma("unroll") for (int m = 0; m < 4; m++) _Pragma("unroll") for (int n = 0; n < 4; n++) acc[m][n] = __builtin_amdgcn_mfma_f32_16x16x32_bf16(bfv[kc][n], af[kc][m], acc[m][n], 0, 0, 0); \
      __builtin_amdgcn_sched_barrier(0); }
#define RBAR { asm volatile("s_waitcnt lgkmcnt(0)" ::: "memory"); __builtin_amdgcn_s_barrier(); asm volatile("" ::: "memory"); }
  GL(ra0, rb0, 0)
  LS(ra0, rb0, 0) RBAR
  for (int kt = 0; kt < nk; kt += 2) {
    GL(ra0, rb0, kt + 1)
    CMP(0)
    LS(ra0, rb0, 1)
    RBAR
    if (kt + 2 < nk) GL(ra0, rb0, kt + 2)
    CMP(1)
    if (kt + 2 < nk) LS(ra0, rb0, 0)
    RBAR
  }
#undef GL
#undef LS
#undef CMP
#undef RBAR
  if (ROWSS) {
    float* rs = (float*)(lds + 73728);
#pragma unroll
    for (int i = 0; i < 4; i++) {
      float v = ss[i]; v += __shfl_xor(v, 1); v += __shfl_xor(v, 2); v += __shfl_xor(v, 4);
      if (lc == 0) rs[lr + 32 * i] = rsqrtf(v / (float)K + eps);
    }
    __syncthreads();
  }
}
__device__ __forceinline__ void gemm_mainloop_d(const bf16_t* __restrict__ Ap, int lda, const bf16_t* __restrict__ Bt, int K,
                                                int m0, int n0, f32x4 (&acc)[4][4], char* lds) {
  const int tid = opaque_tid(), lane = tid & 63, wid = tid >> 6, wr = wid >> 1, wc = wid & 1, fr = lane & 15, fq = lane >> 4;
#pragma unroll
  for (int m = 0; m < 4; m++)
#pragma unroll
    for (int n = 0; n < 4; n++) acc[m][n] = (f32x4){0.f, 0.f, 0.f, 0.f};
  const int nk = K >> 6;
  const int lrow = tid >> 3, cph = tid & 7;
  auto dma = [&](int kt, int st) {
    char* la = lds + st * 32768; char* lb = la + 16384;
#pragma unroll
    for (int i = 0; i < 4; i++) {
      const int row = i * 32 + lrow; const int c = cph ^ ((row >> 1) & 7);
      __builtin_amdgcn_global_load_lds((const unsigned*)(Ap + (size_t)(m0 + row) * lda + kt * 64 + c * 8), (__attribute__((address_space(3))) unsigned*)(la + i * 4096 + tid * 16), 16, 0, 0);
      __builtin_amdgcn_global_load_lds((const unsigned*)(Bt + (size_t)(n0 + row) * K + kt * 64 + c * 8), (__attribute__((address_space(3))) unsigned*)(lb + i * 4096 + tid * 16), 16, 0, 0);
    }
  };
  dma(0, 0);
  asm volatile("s_waitcnt vmcnt(0)" ::: "memory"); __builtin_amdgcn_s_barrier(); asm volatile("" ::: "memory");
  for (int kt = 0; kt < nk; kt++) {
    const int st = kt & 1;
    if (kt + 1 < nk) dma(kt + 1, st ^ 1);
    const char* la = lds + st * 32768; const char* lb = la + 16384;
    bf16x8 af[2][4], bfv[2][4];
#pragma unroll
    for (int kc = 0; kc < 2; kc++) {
#pragma unroll
      for (int m = 0; m < 4; m++) { const int row = wr * 64 + m * 16 + fr; af[kc][m] = *(const bf16x8*)(la + (row * 8 + ((kc * 4 + fq) ^ ((row >> 1) & 7))) * 16); }
#pragma unroll
      for (int n = 0; n < 4; n++) { const int row = wc * 64 + n * 16 + fr; bfv[kc][n] = *(const bf16x8*)(lb + (row * 8 + ((kc * 4 + fq) ^ ((row >> 1) & 7))) * 16); }
    }
    __builtin_amdgcn_s_setprio(1);
#pragma unroll
    for (int kc = 0; kc < 2; kc++)
#pragma unroll
      for (int m = 0; m < 4; m++)
#pragma unroll
        for (int n = 0; n < 4; n++) acc[m][n] = __builtin_amdgcn_mfma_f32_16x16x32_bf16(bfv[kc][n], af[kc][m], acc[m][n], 0, 0, 0);
    __builtin_amdgcn_s_setprio(0);
    asm volatile("s_waitcnt vmcnt(0) lgkmcnt(0)" ::: "memory"); __builtin_amdgcn_s_barrier(); asm volatile("" ::: "memory");
  }
}
__device__ __forceinline__ void gemm_GU_probe(const Params& p, int item, char* lds) {
  const int mt = item / 44, nt = item % 44; const int m0 = mt * 128, n0 = nt * 128;
  f32x4 acc[4][4];
  gemm_mainloop_d((const bf16_t*)(WS(p) + OFF_XB), DM, (const bf16_t*)(WS(p) + OFF_WGU), DM, m0, n0, acc, lds);
  float s = 0.f;
#pragma unroll
  for (int m = 0; m < 4; m++)
#pragma unroll
    for (int n = 0; n < 4; n++) s += acc[m][n][0] + acc[m][n][1] + acc[m][n][2] + acc[m][n][3];
  if (s == 12345.678f) ((float*)(WS(p) + OFF_Z))[opaque_tid()] = s;
}
#define GEMM_IDS const int tid = opaque_tid(), lane = tid & 63, wid = tid >> 6, wr = wid >> 1, wc = wid & 1, fr = lane & 15, fq = lane >> 4; (void)tid;

__device__ __forceinline__ void gemm_A(const Params& p, int item, char* lds) {
  const int mt = item / 18, nt = item % 18; const int m0 = mt * 128, n0 = nt * 128;
  f32x4 acc[4][4];
  gemm_mainloop_d((const bf16_t*)(WS(p) + OFF_XB), DM, (const bf16_t*)(WS(p) + OFF_WIN), DM, m0, n0, acc, lds);
  GEMM_IDS
  const float* rssg = (const float*)(WS(p) + OFF_RSS) + m0;
  bf16_t* P = (bf16_t*)(WS(p) + OFF_P);
#pragma unroll
  for (int m = 0; m < 4; m++) {
    const int rl = wr * 64 + m * 16 + fr; const float r = rsqrtf(rssg[rl] * (1.f / 1024.f) + 1e-6f);
    float sq = 0.f;
#pragma unroll
    for (int n = 0; n < 4; n++) {
      const int col = n0 + wc * 64 + n * 16 + fq * 4;
      if (col < PIN) { f32x4 v = acc[m][n] * r; u32x2 w; w[0] = pk2(v[0], v[1]); w[1] = pk2(v[2], v[3]); *(u32x2*)(P + (size_t)(m0 + rl) * PIN + col) = w;
        const float b0 = bflo(w[0]), b1 = bfhi(w[0]), b2 = bflo(w[1]), b3 = bfhi(w[1]); sq += b0 * b0 + b1 * b1 + b2 * b2 + b3 * b3; }
    }
    if (nt < 4) {
      sq += __shfl_xor(sq, 16); sq += __shfl_xor(sq, 32);
      if (fq == 0) unsafeAtomicAdd((float*)(WS(p) + OFF_RSS) + (2 + (nt >> 1)) * T + m0 + rl, sq);
    }
  }
}
__device__ __forceinline__ void gemm_Q(const Params& p, int item, char* lds) {
  const int mt = item / 6, nt = item % 6; const int m0 = mt * 128, n0 = nt * 128;
  f32x4 acc[4][4];
  gemm_mainloop_d((const bf16_t*)(WS(p) + OFF_P) + C_CQ, PIN, (const bf16_t*)(WS(p) + OFF_WUQ), 256, m0, n0, acc, lds);
  GEMM_IDS
  const float* rsq = (const float*)(WS(p) + OFF_RSS) + 2 * T + m0;
  bf16_t* Q = (bf16_t*)(WS(p) + OFF_Q);
  const float qs = 0.07216878364870322f * 1.4426950408889634f;
  const int cw = n0 + wc * 64; const int h = cw / 192; const int dw = cw - h * 192;
  const bool ispe = (dw == 128);
#pragma unroll
  for (int m = 0; m < 4; m++) {
    const int rl = wr * 64 + m * 16 + fr; const int tok = m0 + rl; const float r = rsqrtf(rsq[rl] * (1.f / 256.f) + 1e-6f) * qs;
    const int b = tok >> 12, s = tok & 4095;
    f32x4 v[4];
#pragma unroll
    for (int n = 0; n < 4; n++) v[n] = acc[m][n] * r;
    if (ispe) {
      const int ps = p.pos[tok];
#pragma unroll
      for (int n = 0; n < 2; n++)
#pragma unroll
        for (int j = 0; j < 4; j++) {
          float c, sn; rope_cs(ps, n * 16 + fq * 4 + j, c, sn);
          const float x1 = v[n][j], x2 = v[n + 2][j];
          v[n][j] = x1 * c - x2 * sn; v[n + 2][j] = x1 * sn + x2 * c;
        }
    }
    bf16_t* dst = Q + ((size_t)((b * 4 + h) * S + s)) * 192 + dw;
#pragma unroll
    for (int n = 0; n < 4; n++) { u32x2 w; w[0] = pk2(v[n][0], v[n][1]); w[1] = pk2(v[n][2], v[n][3]); *(u32x2*)(dst + n * 16 + fq * 4) = w; }
    __builtin_amdgcn_sched_barrier(0);
  }
  __syncthreads();
}
__device__ __forceinline__ void gemm_KV(const Params& p, int item, char* lds) {
  const int mt = item / 8, nt = item % 8; const int m0 = mt * 128, n0 = nt * 128;
  f32x4 acc[4][4];
  gemm_mainloop_d((const bf16_t*)(WS(p) + OFF_P) + C_CKV, PIN, (const bf16_t*)(WS(p) + OFF_WUKV), 256, m0, n0, acc, lds);
  GEMM_IDS
  const float* rsq = (const float*)(WS(p) + OFF_RSS) + 3 * T + m0;
  bf16_t* KN = (bf16_t*)(WS(p) + OFF_KN); bf16_t* VT = (bf16_t*)(WS(p) + OFF_VT);
  const int h = n0 >> 8; const bool isV = (n0 & 128) != 0;
  const int b = m0 >> 12, s0 = m0 & 4095;
  if (!isV) {
#pragma unroll
    for (int m = 0; m < 4; m++) {
      const int rl = wr * 64 + m * 16 + fr; const float r = rsqrtf(rsq[rl] * (1.f / 256.f) + 1e-6f);
#pragma unroll
      for (int n = 0; n < 4; n++) {
        f32x4 v = acc[m][n] * r; const int d = wc * 64 + n * 16 + fq * 4;
        u32x2 w; w[0] = pk2(v[0], v[1]); w[1] = pk2(v[2], v[3]);
        *(u32x2*)(KN + ((size_t)((b * 4 + h) * S + s0 + rl)) * 128 + d) = w;
      }
    }
  } else {
    bf16_t* tl = (bf16_t*)lds;
#pragma unroll
    for (int m = 0; m < 4; m++) {
      const int rl = wr * 64 + m * 16 + fr; const float r = rsqrtf(rsq[rl] * (1.f / 256.f) + 1e-6f);
      const int k32 = rl & 31; const int rlp = (rl & ~31) | ((k32 < 16) ? ((k32 >> 2) * 8 + (k32 & 3)) : (((k32 - 16) >> 2) * 8 + 4 + (k32 & 3)));
#pragma unroll
      for (int n = 0; n < 4; n++) {
        f32x4 v = acc[m][n] * r; const int d = wc * 64 + n * 16 + fq * 4;
#pragma unroll
        for (int j = 0; j < 4; j++) tl[(d + j) * 132 + rlp] = f2bf(v[j]);
      }
    }
    __syncthreads();
    const int dv = tid >> 4, c16 = tid & 15;
#pragma unroll
    for (int i = 0; i < 8; i++) {
      const int row = dv + 16 * i;
      const u32x2 lo = *(const u32x2*)(tl + row * 132 + c16 * 8), hi = *(const u32x2*)(tl + row * 132 + c16 * 8 + 4);
      u32x4 w; w[0] = lo[0]; w[1] = lo[1]; w[2] = hi[0]; w[3] = hi[1];
      *(u32x4*)(VT + ((size_t)((b * 4 + h) * 128 + row)) * S + s0 + c16 * 8) = w;
    }
  }
  __syncthreads();
}
__device__ __forceinline__ void gemm_RES(const bf16_t* A, int K, const bf16_t* Bt, const float* xin, float* xout, bf16_t* xb, float* rss, int item, char* lds) {
  const int mt = item >> 3, nt = item & 7; const int m0 = mt * 128, n0 = nt * 128;
  f32x4 acc[4][4];
  gemm_mainloop_d(A, K, Bt, K, m0, n0, acc, lds);
  GEMM_IDS
#pragma unroll
  for (int m = 0; m < 4; m++) {
    const int rowg = m0 + wr * 64 + m * 16 + fr;
    const size_t ro = (size_t)rowg * DM;
    float sq = 0.f;
#pragma unroll
    for (int n = 0; n < 4; n++) {
      const int col = n0 + wc * 64 + n * 16 + fq * 4;
      f32x4 xv = *(const f32x4*)(xin + ro + col);
      const f32x4 xn = xv + acc[m][n];
      *(f32x4*)(xout + ro + col) = xn;
      u32x2 w; w[0] = pk2(xn[0], xn[1]); w[1] = pk2(xn[2], xn[3]); *(u32x2*)(xb + ro + col) = w;
      const float b0 = bflo(w[0]), b1 = bfhi(w[0]), b2 = bflo(w[1]), b3 = bfhi(w[1]);
      sq += b0 * b0 + b1 * b1 + b2 * b2 + b3 * b3;
    }
    sq += __shfl_xor(sq, 16); sq += __shfl_xor(sq, 32);
    if (fq == 0) unsafeAtomicAdd(rss + rowg, sq);
  }
}
__device__ __forceinline__ void gemm_GU(const Params& p, int item, char* lds) {
  const int r_ = item >> 9, x_ = item & 7, y_ = (item >> 3) & 63;
  const int pid = (r_ * 8 + x_) * 2 + (y_ >> 5), t32 = y_ & 31;
  const int mt = (pid / 11) * 8 + (t32 >> 2), nt = (pid % 11) * 4 + (t32 & 3); const int m0 = mt * 128, n0 = nt * 128;
  f32x4 acc[4][4];
  gemm_mainloop_d((const bf16_t*)(WS(p) + OFF_XB), DM, (const bf16_t*)(WS(p) + OFF_WGU), DM, m0, n0, acc, lds);
  GEMM_IDS
  const float* rssg = (const float*)(WS(p) + OFF_RSS) + T + m0;
  bf16_t* U = (bf16_t*)(WS(p) + OFF_U);
#pragma unroll
  for (int m = 0; m < 4; m++) {
    const int rl = wr * 64 + m * 16 + fr; const float r = rsqrtf(rssg[rl] * (1.f / 1024.f) + 1e-6f);
#pragma unroll
    for (int i = 0; i < 2; i++) {
      f32x4 g = acc[m][2 * i] * r, u = acc[m][2 * i + 1] * r, o;
#pragma unroll
      for (int j = 0; j < 4; j++) o[j] = g[j] * sigmoidf_(g[j]) * u[j];
      const int col = (n0 >> 1) + wc * 32 + i * 16 + fq * 4;
      u32x2 w; w[0] = pk2(o[0], o[1]); w[1] = pk2(o[2], o[3]);
      *(u32x2*)(U + (size_t)(m0 + rl) * DFF + col) = w;
    }
  }
  __syncthreads();
}

__device__ __forceinline__ void rwkv_prep_item(const Params& p, int l, int item, char* ldsraw) {
  float* lds = (float*)ldsraw;
  const bf16_t* P = (const bf16_t*)(WS(p) + OFF_P);
  float* RW = (float*)(WS(p) + OFF_RW); bf16_t* RB = (bf16_t*)(WS(p) + OFF_RB); float* RC = (float*)(WS(p) + OFF_RC);
  const int tid = opaque_tid(), h = tid >> 6, jl = tid & 63;
  const int tok0 = item * 16, b = tok0 >> 12, s0 = tok0 & 4095;
  const float* mu = p.mu + l * 896;
#pragma unroll
  for (int i = 0; i < 4; i++) {
    int idx = tid + 256 * i; int t = idx >> 6, c = idx & 63;
    int col = C_RW + 768 + c; int tok = tok0 + t;
    float cur = bf2f(P[(size_t)tok * PIN + col]);
    float prv = (s0 + t > 0) ? bf2f(P[(size_t)(tok - 1) * PIN + col]) : 0.f;
    float v = cur + (prv - cur) * mu[768 + c];
    if (c < 32) { float e = __expf(2.f * v); v = 1.f - 2.f / (1.f + e); }
    lds[t * 64 + c] = v;
  }
  __syncthreads();
  {
    float wl[16], al[16];
    const float w0j = p.w0[l * 256 + tid], a0j = p.a0[l * 256 + tid];
#pragma unroll
    for (int t = 0; t < 16; t++) { wl[t] = w0j; al[t] = a0j; }
    const float* w2 = p.w2 + (size_t)l * 32 * 256 + tid; const float* a2 = p.a2 + (size_t)l * 32 * 256 + tid;
    float w2c[32], a2c[32];
#pragma unroll
    for (int i = 0; i < 32; i++) { w2c[i] = w2[i * 256]; a2c[i] = a2[i * 256]; }
#pragma unroll
    for (int i4 = 0; i4 < 8; i4++) {
#pragma unroll
      for (int t = 0; t < 16; t++) {
        const f32x4 xw = *(const f32x4*)(lds + t * 64 + i4 * 4), xa = *(const f32x4*)(lds + t * 64 + 32 + i4 * 4);
        wl[t] += xw[0] * w2c[i4 * 4] + xw[1] * w2c[i4 * 4 + 1] + xw[2] * w2c[i4 * 4 + 2] + xw[3] * w2c[i4 * 4 + 3];
        al[t] += xa[0] * a2c[i4 * 4] + xa[1] * a2c[i4 * 4 + 1] + xa[2] * a2c[i4 * 4 + 2] + xa[3] * a2c[i4 * 4 + 3];
      }
    }
#pragma unroll
    for (int t = 0; t < 16; t++) { lds[1024 + t * 256 + tid] = wl[t]; lds[1024 + 4096 + t * 256 + tid] = al[t]; }
  }
  const float kkj = p.k_k[l * 256 + tid], kaj = p.k_a[l * 256 + tid], rkj = p.r_k[l * 256 + tid];
  const float mur = mu[tid], muk = mu[256 + tid], muv = mu[512 + tid];
  bf16_t* stg = (bf16_t*)(lds + 9216);
  {
    u32x4 sv[7];
#pragma unroll
    for (int k = 0; k < 7; k++) {
      const int c = tid + 256 * k; const int cc2 = (c < 17 * 96) ? c : 0; const int rw = cc2 / 96, cc = cc2 - rw * 96;
      const int rr = (rw > 0 || s0 > 0) ? rw : 1;
      sv[k] = *(const u32x4*)(P + (size_t)(tok0 + rr - 1) * PIN + C_RW + cc * 8);
    }
#pragma unroll
    for (int k = 0; k < 7; k++) {
      const int c = tid + 256 * k; const int rw = c / 96, cc = c - rw * 96;
      u32x4 w = sv[k]; if (rw == 0 && s0 == 0) w = (u32x4){0u, 0u, 0u, 0u};
      if (c < 17 * 96) *(u32x4*)(stg + rw * 768 + cc * 8) = w;
    }
  }
  __syncthreads();
#pragma unroll 2
  for (int t = 0; t < 16; t++) {
    const int s = s0 + t;
    const bf16_t* pc = stg + (t + 1) * 768; const bf16_t* pp = stg + t * 768;
    float r = bf2f(pc[tid]), k = bf2f(pc[256 + tid]), v = bf2f(pc[512 + tid]);
    const float rp = bf2f(pp[tid]), kp = bf2f(pp[256 + tid]), vp = bf2f(pp[512 + tid]);
    r += (rp - r) * mur; k += (kp - k) * muk; v += (vp - v) * muv;
    const float wl = lds[1024 + t * 256 + tid], al = lds[1024 + 4096 + t * 256 + tid];
    const float decay = __expf(-0.6065306597126334f * sigmoidf_(wl));
    const float a = sigmoidf_(al);
    const float kkr = k * kkj;
    const float ssq = wave_sum(kkr * kkr);
    const float kk = kkr * rsqrtf(fmaxf(ssq, 1e-24f));
    const float km = k * (1.f + (a - 1.f) * kaj);
    const float kka = kk * a, wr = decay * r;
    const float c1 = wave_sum(kka * r), c2 = wave_sum(km * r), c3 = wave_sum(r * km * rkj);
    const size_t base = (size_t)(b * 4 + h) * S + s;
    RW[base * 64 + jl] = decay;
    bf16_t* rb = RB + base * 320;
    rb[jl] = f2bf(kk); rb[64 + jl] = f2bf(kka); rb[128 + jl] = f2bf(km); rb[192 + jl] = f2bf(wr); rb[256 + jl] = f2bf(v);
    if (jl == 0) { f32x4 c; c[0] = c1; c[1] = c2; c[2] = c3; c[3] = 0.f; *(f32x4*)(RC + base * 4) = c; }
  }
  bf16_t* KPE = (bf16_t*)(WS(p) + OFF_KPE);
#pragma unroll
  for (int i = 0; i < 2; i++) {
    int idx = tid + 256 * i; int t = idx >> 5, f = idx & 31; int tok = tok0 + t;
    float x1 = bf2f(P[(size_t)tok * PIN + C_KPE + f]), x2 = bf2f(P[(size_t)tok * PIN + C_KPE + 32 + f]);
    float c, sn; rope_cs(p.pos[tok], f, c, sn);
    KPE[(size_t)tok * 64 + f] = f2bf(x1 * c - x2 * sn); KPE[(size_t)tok * 64 + 32 + f] = f2bf(x1 * sn + x2 * c);
  }
  __syncthreads();
}

template <int VAR>
__device__ __forceinline__ void rwkv_scan_item(const Params& p, int item, char* ldsraw) {
  const float* RW = (const float*)(WS(p) + OFF_RW); const bf16_t* RB = (const bf16_t*)(WS(p) + OFF_RB); const float* RC = (const float*)(WS(p) + OFF_RC);
  bf16_t* YR = (bf16_t*)(WS(p) + (VAR ? OFF_Q : OFF_Y));
  float* buf = (float*)ldsraw;
  constexpr int STEP = 340;
  const int bh = item >> 2, rq = item & 3, b = bh >> 2, h = bh & 3;
  const int tid = opaque_tid(), lane = tid & 63, wid = tid >> 6, jl = lane & 15, rl = lane >> 4;
  const int row = rq * 16 + wid * 4 + rl;
  const int st = tid >> 4, part = tid & 15;
  f32x4 pw; u32x2 pkk, pkka, pk, pwr; unsigned short pv; float pc;
  auto load = [&](int chunk) {
    const size_t base = (size_t)bh * S + chunk * 16 + st;
    pw = *(const f32x4*)(RW + base * 64 + part * 4);
    const bf16_t* rb = RB + base * 320;
    pkk = *(const u32x2*)(rb + part * 4); pkka = *(const u32x2*)(rb + 64 + part * 4);
    pk = *(const u32x2*)(rb + 128 + part * 4); pwr = *(const u32x2*)(rb + 192 + part * 4);
    pv = rb[256 + rq * 16 + part];
    pc = (part < 2) ? RC[base * 4 + part] : 0.f;
  };
  auto store = [&](int bi) {
    float* d = buf + bi * 16 * STEP + st * STEP;
    *(f32x4*)(d + part * 4) = pw;
    *(f32x4*)(d + 64 + part * 4) = (f32x4){bflo(pkk[0]), bfhi(pkk[0]), bflo(pkk[1]), bfhi(pkk[1])};
    *(f32x4*)(d + 128 + part * 4) = (f32x4){bflo(pkka[0]), bfhi(pkka[0]), bflo(pkka[1]), bfhi(pkka[1])};
    *(f32x4*)(d + 192 + part * 4) = (f32x4){bflo(pk[0]), bfhi(pk[0]), bflo(pk[1]), bfhi(pk[1])};
    *(f32x4*)(d + 256 + part * 4) = (f32x4){bflo(pwr[0]), bfhi(pwr[0]), bflo(pwr[1]), bfhi(pwr[1])};
    d[320 + part] = bf2f(pv);
    if (part < 2) d[336 + part] = pc;
  };
  __builtin_amdgcn_s_setprio(3);
  load(0); store(0); __syncthreads();
  float s0 = 0.f, s1 = 0.f, s2 = 0.f, s3 = 0.f;
  bf16_t* yout = YR + ((size_t)b * S + jl) * 1024 + 512 + h * 64 + row;
#define SCAN_LOAD(q) { const float* ds_ = d + (q) * STEP; nw = *(const f32x4*)(ds_); nkk = *(const f32x4*)(ds_ + 64); nkka = *(const f32x4*)(ds_ + 128); \
    nk = *(const f32x4*)(ds_ + 192); nwr = *(const f32x4*)(ds_ + 256); nv = dvp[(q) * STEP]; ncc = *(const f32x2*)(dcp + (q) * STEP); }
#pragma unroll 1
  for (int c = 0; c < 256; c++) {
    if (c + 1 < 256) load(c + 1);
    const float* d = buf + (c & 1) * 16 * STEP + jl * 4;
    const float* dvp = buf + (c & 1) * 16 * STEP + 320 + wid * 4 + rl;
    const float* dcp = buf + (c & 1) * 16 * STEP + 336;
    f32x4 nw, nkk, nkka, nk, nwr; float nv; f32x2 ncc;
    SCAN_LOAD(0)
    float ykeep = 0.f;
#pragma unroll
    for (int q = 0; q < (VAR == 4 ? 0 : 16); q++) {
      const f32x4 cw = nw, ckk = nkk, ckka = nkka, ck = nk, cwr = nwr; const float cv = nv; const f32x2 ccc = ncc;
      if (q < 15 && VAR != 3) SCAN_LOAD(q + 1)
      __builtin_amdgcn_sched_barrier(0);
      float m0 = mul_s(s0, ckk.x), m1 = mul_s(s2, ckk.z), n0 = mul_s(s0, cwr.x), n1 = mul_s(s2, cwr.z);
      m0 = fma_s(s1, ckk.y, m0); m1 = fma_s(s3, ckk.w, m1); n0 = fma_s(s1, cwr.y, n0); n1 = fma_s(s3, cwr.w, n1);
      float psa = add_s(m0, m1), pu = add_s(n0, n1);
      if (VAR != 2) { psa = row16_sum(psa); pu = row16_sum(pu); }
      const float t0 = fnma_s(psa, ckka.x, mul_s(cv, ck.x)), t1 = fnma_s(psa, ckka.y, mul_s(cv, ck.y));
      const float t2 = fnma_s(psa, ckka.z, mul_s(cv, ck.z)), t3 = fnma_s(psa, ckka.w, mul_s(cv, ck.w));
      s0 = fma_s(s0, cw.x, t0); s1 = fma_s(s1, cw.y, t1); s2 = fma_s(s2, cw.z, t2); s3 = fma_s(s3, cw.w, t3);
      const float y = fnma_s(psa, ccc.x, fma_s(cv, ccc.y, pu));
      ykeep = sel_eq(ykeep, y, jl, q);
    }
    if (c + 1 < 256) store((c + 1) & 1);
    __builtin_amdgcn_sched_barrier(0);
    yout[(size_t)c * 16 * 1024] = f2bf(ykeep);
    __syncthreads();
  }
#undef SCAN_LOAD
  __builtin_amdgcn_s_setprio(0);
}

__device__ __forceinline__ void rwkv_scan2_item(const Params& p, int item, char* ldsraw) {
  const float* RW = (const float*)(WS(p) + OFF_RW); const bf16_t* RB = (const bf16_t*)(WS(p) + OFF_RB); const float* RC = (const float*)(WS(p) + OFF_RC);
  bf16_t* Yb = (bf16_t*)(WS(p) + OFF_Y);
  float* buf = (float*)ldsraw;
  constexpr int STEP = 340, CH = 16 * STEP;
  float* SA = buf + 3 * CH;
  const int bh = item / 12, rr = item - bh * 12, b = bh >> 2, h = bh & 3;
  const int seg = (rr >= 4) ? 1 : 0, ident = (rr >= 8) ? 1 : 0, r16 = rr & 3;
  const int c0 = seg * 128;
  const int tid = opaque_tid(), lane = tid & 63, wid = tid >> 6, jl = lane & 15, rl = lane >> 4;
  const int isY = wid >> 1, row8 = (wid & 1) * 4 + rl;
  const int rowA = r16 * 16 + row8;
  const int st = tid >> 4, part = tid & 15;
  f32x4 pw; u32x2 pkk, pkka, pk, pwr; unsigned short pv; float pc;
  auto load = [&](int chunk) {
    const size_t base = (size_t)bh * S + chunk * 16 + st;
    pw = *(const f32x4*)(RW + base * 64 + part * 4);
    const bf16_t* rb = RB + base * 320;
    pkk = *(const u32x2*)(rb + part * 4); pkka = *(const u32x2*)(rb + 64 + part * 4);
    pk = *(const u32x2*)(rb + 128 + part * 4); pwr = *(const u32x2*)(rb + 192 + part * 4);
    pv = rb[256 + r16 * 16 + part];
    pc = (part < 2) ? RC[base * 4 + part] : 0.f;
  };
  auto store = [&](int bi) {
    float* d = buf + bi * CH + st * STEP;
    *(f32x4*)(d + part * 4) = pw;
    *(f32x4*)(d + 64 + part * 4) = (f32x4){bflo(pkk[0]), bfhi(pkk[0]), bflo(pkk[1]), bfhi(pkk[1])};
    *(f32x4*)(d + 128 + part * 4) = (f32x4){bflo(pkka[0]), bfhi(pkka[0]), bflo(pkka[1]), bfhi(pkka[1])};
    *(f32x4*)(d + 192 + part * 4) = (f32x4){bflo(pk[0]), bfhi(pk[0]), bflo(pk[1]), bfhi(pk[1])};
    *(f32x4*)(d + 256 + part * 4) = (f32x4){bflo(pwr[0]), bfhi(pwr[0]), bflo(pwr[1]), bfhi(pwr[1])};
    d[320 + part] = ident ? 0.f : bf2f(pv);
    if (part < 2) d[336 + part] = pc;
  };
  load(c0); store(0); __syncthreads();
  float a0 = 0.f, a1 = 0.f, a2 = 0.f, a3 = 0.f, b0 = 0.f, b1 = 0.f, b2 = 0.f, b3 = 0.f;
  if (ident) {
    const int mA = rowA - jl * 4, mB = mA + 8;
    a0 = (mA == 0) ? 1.f : 0.f; a1 = (mA == 1) ? 1.f : 0.f; a2 = (mA == 2) ? 1.f : 0.f; a3 = (mA == 3) ? 1.f : 0.f;
    b0 = (mB == 0) ? 1.f : 0.f; b1 = (mB == 1) ? 1.f : 0.f; b2 = (mB == 2) ? 1.f : 0.f; b3 = (mB == 3) ? 1.f : 0.f;
  }
  bf16_t* yout = ident ? (bf16_t*)(WS(p) + OFF_Z) + ((size_t)bh * 2048 + jl) * 64 + rowA
                       : Yb + ((size_t)b * S + c0 * 16 + jl) * 1024 + 512 + h * 64 + rowA;
  const size_t ystride = ident ? (size_t)16 * 64 : (size_t)16 * 1024;
  int bi = 0;
#pragma unroll 1
  for (int c = 0; c <= 128; c++) {
    if (c + 1 < 128) load(c0 + c + 1);
    const int bprev = (bi == 0) ? 2 : bi - 1, bnext = (bi == 2) ? 0 : bi + 1;
    if (!isY) {
      if (c < 128) {
        const float* d = buf + bi * CH + jl * 4;
        const float* dvp = buf + bi * CH + 320 + row8;
        f32x4 nw, nkk, nkka, nk; float nvA, nvB;
#define R_LOAD(q) { const float* ds_ = d + (q) * STEP; nw = *(const f32x4*)(ds_); nkk = *(const f32x4*)(ds_ + 64); nkka = *(const f32x4*)(ds_ + 128); nk = *(const f32x4*)(ds_ + 192); nvA = dvp[(q) * STEP]; nvB = dvp[(q) * STEP + 8]; }
        R_LOAD(0)
        float sakA = 0.f, sakB = 0.f;
#pragma unroll
        for (int q = 0; q < 16; q++) {
          const f32x4 cw = nw, ckk = nkk, ckka = nkka, ck = nk; const float cvA = nvA, cvB = nvB;
          if (q < 15) R_LOAD(q + 1)
          __builtin_amdgcn_sched_barrier(0);
          float mA0 = mul_s(a0, ckk.x), mA1 = mul_s(a2, ckk.z), mB0 = mul_s(b0, ckk.x), mB1 = mul_s(b2, ckk.z);
          mA0 = fma_s(a1, ckk.y, mA0); mA1 = fma_s(a3, ckk.w, mA1); mB0 = fma_s(b1, ckk.y, mB0); mB1 = fma_s(b3, ckk.w, mB1);
          float psA = add_s(mA0, mA1), psB = add_s(mB0, mB1);
          psA = row16_sum(psA); psB = row16_sum(psB);
          { const float t0 = fnma_s(psA, ckka.x, mul_s(cvA, ck.x)), t1 = fnma_s(psA, ckka.y, mul_s(cvA, ck.y));
            const float t2 = fnma_s(psA, ckka.z, mul_s(cvA, ck.z)), t3 = fnma_s(psA, ckka.w, mul_s(cvA, ck.w));
            a0 = fma_s(a0, cw.x, t0); a1 = fma_s(a1, cw.y, t1); a2 = fma_s(a2, cw.z, t2); a3 = fma_s(a3, cw.w, t3); }
          { const float t0 = fnma_s(psB, ckka.x, mul_s(cvB, ck.x)), t1 = fnma_s(psB, ckka.y, mul_s(cvB, ck.y));
            const float t2 = fnma_s(psB, ckka.z, mul_s(cvB, ck.z)), t3 = fnma_s(psB, ckka.w, mul_s(cvB, ck.w));
            b0 = fma_s(b0, cw.x, t0); b1 = fma_s(b1, cw.y, t1); b2 = fma_s(b2, cw.z, t2); b3 = fma_s(b3, cw.w, t3); }
          sakA = sel_eq(sakA, psA, jl, q); sakB = sel_eq(sakB, psB, jl, q);
        }
#undef R_LOAD
        SA[(c & 1) * 256 + jl * 16 + row8] = sakA; SA[(c & 1) * 256 + jl * 16 + 8 + row8] = sakB;
      }
    } else {
      if (c >= 1) {
        const float* d = buf + bprev * CH + jl * 4;
        const float* dvp = buf + bprev * CH + 320 + row8;
        const float* dcp = buf + bprev * CH + 336;
        const float* sap = SA + ((c - 1) & 1) * 256 + row8;
        f32x4 nw, nkka, nk, nwr; float nvA, nvB, nsA, nsB; f32x2 ncc;
#define Y_LOAD(q) { const float* ds_ = d + (q) * STEP; nw = *(const f32x4*)(ds_); nkka = *(const f32x4*)(ds_ + 128); nk = *(const f32x4*)(ds_ + 192); nwr = *(const f32x4*)(ds_ + 256); \
          nvA = dvp[(q) * STEP]; nvB = dvp[(q) * STEP + 8]; ncc = *(const f32x2*)(dcp + (q) * STEP); nsA = sap[(q) * 16]; nsB = sap[(q) * 16 + 8]; }
        Y_LOAD(0)
        float ykA = 0.f, ykB = 0.f;
#pragma unroll
        for (int q = 0; q < 16; q++) {
          const f32x4 cw = nw, ckka = nkka, ck = nk, cwr = nwr; const float cvA = nvA, cvB = nvB, psA = nsA, psB = nsB; const f32x2 ccc = ncc;
          if (q < 15) Y_LOAD(q + 1)
          __builtin_amdgcn_sched_barrier(0);
          float nA0 = mul_s(a0, cwr.x), nA1 = mul_s(a2, cwr.z), nB0 = mul_s(b0, cwr.x), nB1 = mul_s(b2, cwr.z);
          nA0 = fma_s(a1, cwr.y, nA0); nA1 = fma_s(a3, cwr.w, nA1); nB0 = fma_s(b1, cwr.y, nB0); nB1 = fma_s(b3, cwr.w, nB1);
          float puA = add_s(nA0, nA1), puB = add_s(nB0, nB1);
          puA = row16_sum(puA); puB = row16_sum(puB);
          { const float t0 = fnma_s(psA, ckka.x, mul_s(cvA, ck.x)), t1 = fnma_s(psA, ckka.y, mul_s(cvA, ck.y));
            const float t2 = fnma_s(psA, ckka.z, mul_s(cvA, ck.z)), t3 = fnma_s(psA, ckka.w, mul_s(cvA, ck.w));
            a0 = fma_s(a0, cw.x, t0); a1 = fma_s(a1, cw.y, t1); a2 = fma_s(a2, cw.z, t2); a3 = fma_s(a3, cw.w, t3); }
          { const float t0 = fnma_s(psB, ckka.x, mul_s(cvB, ck.x)), t1 = fnma_s(psB, ckka.y, mul_s(cvB, ck.y));
            const float t2 = fnma_s(psB, ckka.z, mul_s(cvB, ck.z)), t3 = fnma_s(psB, ckka.w, mul_s(cvB, ck.w));
            b0 = fma_s(b0, cw.x, t0); b1 = fma_s(b1, cw.y, t1); b2 = fma_s(b2, cw.z, t2); b3 = fma_s(b3, cw.w, t3); }
          const float yA = fnma_s(psA, ccc.x, fma_s(cvA, ccc.y, puA)), yB = fnma_s(psB, ccc.x, fma_s(cvB, ccc.y, puB));
          ykA = sel_eq(ykA, yA, jl, q); ykB = sel_eq(ykB, yB, jl, q);
        }
#undef Y_LOAD
        yout[(size_t)(c - 1) * ystride] = f2bf(ykA); yout[(size_t)(c - 1) * ystride + 8] = f2bf(ykB);
      }
    }
    if (c + 1 < 128) store(bnext);
    bi = bnext;
    asm volatile("s_waitcnt lgkmcnt(0)" ::: "memory"); __builtin_amdgcn_s_barrier(); asm volatile("" ::: "memory");
  }
  if (seg == 0 && !isY) {
    float* sf = (float*)(WS(p) + OFF_SF) + ((size_t)bh * 64 + rowA) * 64 + jl * 4;
    *(f32x4*)sf = (f32x4){a0, a1, a2, a3}; *(f32x4*)(sf + 8 * 64) = (f32x4){b0, b1, b2, b3};
  }
}

__device__ __forceinline__ void rwkv_fin_item(const Params& p, int l, int item, char* ldsraw) {
  float* lds = (float*)ldsraw;
  const bf16_t* P = (const bf16_t*)(WS(p) + OFF_P);
  const bf16_t* RB = (const bf16_t*)(WS(p) + OFF_RB); const float* RC = (const float*)(WS(p) + OFF_RC);
  bf16_t* Y = (bf16_t*)(WS(p) + OFF_Y);
  const int tid = opaque_tid(), h = tid >> 6, jl = tid & 63;
  const int tok0 = item * 16, b = tok0 >> 12, s0 = tok0 & 4095;
  const float* mu = p.mu + l * 896;
#pragma unroll
  for (int i = 0; i < 4; i++) {
    int idx = tid + 256 * i; int t = idx >> 6, c = idx & 63;
    int col = C_RW + 832 + c; int tok = tok0 + t;
    float cur = bf2f(P[(size_t)tok * PIN + col]);
    float prv = (s0 + t > 0) ? bf2f(P[(size_t)(tok - 1) * PIN + col]) : 0.f;
    float v = cur + (prv - cur) * mu[832 + c];
    lds[t * 64 + c] = sigmoidf_(v);
  }
  __syncthreads();
  {
    float gacc[16];
#pragma unroll
    for (int t = 0; t < 16; t++) gacc[t] = 0.f;
    const float* g2 = p.g2 + (size_t)l * 64 * 256 + tid;
    float g2c[64];
#pragma unroll
    for (int i = 0; i < 64; i++) g2c[i] = g2[i * 256];
#pragma unroll
    for (int i4 = 0; i4 < 16; i4++) {
#pragma unroll
      for (int t = 0; t < 16; t++) {
        const f32x4 x = *(const f32x4*)(lds + t * 64 + i4 * 4);
        gacc[t] += x[0] * g2c[i4 * 4] + x[1] * g2c[i4 * 4 + 1] + x[2] * g2c[i4 * 4 + 2] + x[3] * g2c[i4 * 4 + 3];
      }
    }
#pragma unroll
    for (int t = 0; t < 16; t++) lds[1024 + t * 256 + tid] = gacc[t];
  }
  const float lw = p.ln_w[l * 256 + tid], lb = p.ln_b[l * 256 + tid];
  float yv[16], vv[16], c3v[16];
  const size_t base0 = (size_t)(b * 4 + h) * S + s0;
#pragma unroll
  for (int t = 0; t < 16; t++) { yv[t] = bf2f(Y[(size_t)(tok0 + t) * 1024 + 512 + tid]); vv[t] = bf2f(RB[(base0 + t) * 320 + 256 + jl]); c3v[t] = RC[(base0 + t) * 4 + 2]; }
  if (s0 >= 2048) {
    float* zl = lds + 5120;
    const bf16_t* Z = (const bf16_t*)(WS(p) + OFF_Z);
#pragma unroll
    for (int t = 0; t < 16; t++) zl[t * 256 + tid] = bf2f(Z[((size_t)(b * 4 + h) * 2048 + (s0 - 2048 + t)) * 64 + jl]);
    const float* sf = (const float*)(WS(p) + OFF_SF) + ((size_t)(b * 4 + h) * 64 + jl) * 64;
    __syncthreads();
#pragma unroll 1
    for (int mq = 0; mq < 16; mq++) {
      const f32x4 sv = *(const f32x4*)(sf + mq * 4);
#pragma unroll
      for (int t = 0; t < 16; t++) {
        const f32x4 zv = *(const f32x4*)(zl + t * 256 + h * 64 + mq * 4);
        yv[t] += sv[0] * zv[0] + sv[1] * zv[1] + sv[2] * zv[2] + sv[3] * zv[3];
      }
    }
  }
#pragma unroll
  for (int t = 0; t < 16; t++) {
    const float y = yv[t];
    const float mean = wave_sum(y) * (1.f / 64.f);
    const float dlt = y - mean;
    const float var = wave_sum(dlt * dlt) * (1.f / 64.f);
    const float yn = dlt * rsqrtf(var + 64e-5f) * lw + lb;
    const float g = lds[1024 + t * 256 + tid];
    Y[(size_t)(tok0 + t) * 1024 + 512 + tid] = f2bf((yn + c3v[t] * vv[t]) * g);
  }
  __syncthreads();
}

__device__ __forceinline__ float wave_scan_add_lds(volatile float* a, int t, float v) {
  a[t] = v;
#pragma unroll
  for (int o = 1; o < 64; o <<= 1) { const float u = (t >= o) ? a[t - o] : 0.f; v += u; a[t] = v; }
  return v;
}
__device__ __forceinline__ float wave_scan_max_lds(volatile float* a, int t, float v) {
  a[t] = v;
#pragma unroll
  for (int o = 1; o < 64; o <<= 1) { const float u = (t >= o) ? a[t - o] : -3.0e38f; v = fmaxf(v, u); a[t] = v; }
  return v;
}
__device__ __forceinline__ float ml_conv(const bf16_t* P, const float* cw, const float* cb, int tok, int s, int ch) {
  float acc = cb[ch];
  float xv[4], wv[4];
#pragma unroll
  for (int j = 0; j < 4; j++) { const int ds = 3 - j; const bool ok = (s - ds >= 0); const int tk = ok ? tok - ds : tok; xv[j] = bf2f(P[(size_t)tk * PIN + C_ML + ch]); wv[j] = ok ? cw[j * 256 + ch] : 0.f; }
#pragma unroll
  for (int j = 0; j < 4; j++) acc += xv[j] * wv[j];
  return acc * sigmoidf_(acc);
}
__device__ __forceinline__ void ml_stage_qk(const bf16_t* P, const float* cw, const float* cb, bf16_t* raw, float* wl, int tokb, int c, int h, int tid) {
  for (int ci = tid; ci < 67 * 8; ci += 256) {
    const int row = ci >> 3, c8 = ci & 7;
    u32x4 w = {0u, 0u, 0u, 0u};
    if (c * 64 - 3 + row >= 0) w = *(const u32x4*)(P + (size_t)(tokb - 3 + row) * PIN + C_ML + ((c8 < 4) ? (h * 32 + c8 * 8) : (128 + h * 32 + (c8 - 4) * 8)));
    *(u32x4*)(raw + row * 64 + c8 * 8) = w;
  }
  for (int i = tid; i < 320; i += 256) {
    const int x = i & 63; const int ch = (x < 32) ? (h * 32 + x) : (128 + h * 32 + (x - 32));
    wl[i] = (i < 256) ? cw[(i >> 6) * 256 + ch] : cb[ch];
  }
}
__device__ __forceinline__ float ml_conv_lds(const bf16_t* raw, const float* wl, int t, int ch) {
  float acc = wl[256 + ch];
#pragma unroll
  for (int j = 0; j < 4; j++) acc += bf2f(raw[(t + j) * 64 + ch]) * wl[j * 64 + ch];
  return acc * sigmoidf_(acc);
}
__device__ __forceinline__ void ml_p1_item(const Params& p, int l, int item, char* ldsraw) {
  float* lds = (float*)ldsraw;
  float* Ks = lds;
  float* Vs = lds + 2112;
  float* G = lds + 2112 + 4096;
  const bf16_t* P = (const bf16_t*)(WS(p) + OFF_P);
  const int bh = item >> 6, c = item & 63, b = bh >> 2, h = bh & 3;
  const int tid = opaque_tid();
  const int tokb = b * S + c * 64;
  const float* cw = p.conv_w + l * 1024; const float* cb = p.conv_b + l * 256;
  {
    bf16_t* raw = (bf16_t*)(lds + 6400); float* wl = lds + 6400 + 2144;
    ml_stage_qk(P, cw, cb, raw, wl, tokb, c, h, tid);
#pragma unroll
    for (int i = 0; i < 2; i++) {
      const int ci = tid + 256 * i; const int row = ci >> 3, c8 = ci & 7;
      const u32x4 w = *(const u32x4*)(P + (size_t)(tokb + row) * PIN + C_ML + 256 + h * 64 + c8 * 8);
      *(f32x4*)(Vs + row * 64 + c8 * 8) = (f32x4){bflo(w[0]), bfhi(w[0]), bflo(w[1]), bfhi(w[1])};
      *(f32x4*)(Vs + row * 64 + c8 * 8 + 4) = (f32x4){bflo(w[2]), bfhi(w[2]), bflo(w[3]), bfhi(w[3])};
    }
    __syncthreads();
    const int t = tid >> 2, dq = tid & 3;
#pragma unroll
    for (int i = 0; i < 8; i++) { int d = dq * 8 + i; Ks[t * 33 + d] = ml_conv_lds(raw, wl, t, 32 + d); }
  }
  float glast = 0.f, amax = 0.f;
  if (tid < 64) {
    const int t = tid;
    const float ip = bf2f(P[(size_t)(tokb + t) * PIN + C_ML + 512 + h]) + p.i_bias[l * 4 + h];
    const float fp = bf2f(P[(size_t)(tokb + t) * PIN + C_ML + 516 + h]) + p.f_bias[l * 4 + h];
    const float lf = fminf(fp, 0.f) - log1pf(__expf(-fabsf(fp)));
    volatile float* sc = G + 64;
    const float g = wave_scan_add_lds(sc, t, lf);
    glast = sc[63];
    const float a = glast - g + ip;
    amax = wave_scan_max_lds(sc + 64, t, a);
    amax = sc[64 + 63];
    G[t] = __expf(a - amax);
  }
  __syncthreads();
  {
    const int d = tid >> 3, e0 = (tid & 7) * 8;
    float accv[8]; float nacc = 0.f;
#pragma unroll
    for (int i = 0; i < 8; i++) accv[i] = 0.f;
    for (int t = 0; t < 64; t++) {
      const float kw = G[t] * Ks[t * 33 + d];
      const f32x4 v0 = *(const f32x4*)(Vs + t * 64 + e0), v1 = *(const f32x4*)(Vs + t * 64 + e0 + 4);
      accv[0] += kw * v0[0]; accv[1] += kw * v0[1]; accv[2] += kw * v0[2]; accv[3] += kw * v0[3];
      accv[4] += kw * v1[0]; accv[5] += kw * v1[1]; accv[6] += kw * v1[2]; accv[7] += kw * v1[3];
      nacc += kw;
    }
    float* MLC = (float*)(WS(p) + OFF_MLC) + (size_t)item * 2048 + d * 64 + e0;
    *(f32x4*)MLC = (f32x4){accv[0], accv[1], accv[2], accv[3]};
    *(f32x4*)(MLC + 4) = (f32x4){accv[4], accv[5], accv[6], accv[7]};
    if ((tid & 7) == 0) ((float*)(WS(p) + OFF_MLN))[(size_t)item * 32 + d] = nacc;
  }
  if (tid == 0) { float* ms = (float*)(WS(p) + OFF_MLS) + (size_t)item * 4; ms[0] = glast; ms[1] = amax; }
  __syncthreads();
}
__device__ __forceinline__ void ml_p2_item(const Params& p, int bh, unsigned* flag, char* ldsraw) {
  float* lds = (float*)ldsraw;
  const int tid = opaque_tid();
  float* MLS = (float*)(WS(p) + OFF_MLS) + (size_t)bh * 64 * 4;
  float* MLC = (float*)(WS(p) + OFF_MLC) + (size_t)bh * 64 * 2048;
  float* MLN = (float*)(WS(p) + OFF_MLN) + (size_t)bh * 64 * 32;
  if (tid == 0) {
    float m = 0.f;
    for (int c = 0; c < 64; c++) {
      const float gl = MLS[c * 4 + 0], am = MLS[c * 4 + 1];
      const float mn = fmaxf(gl + m, am);
      lds[c] = __expf(gl + m - mn); lds[64 + c] = __expf(am - mn);
      MLS[c * 4 + 2] = m;
      m = mn;
    }
  }
  __syncthreads();
  f32x4 C0 = {0.f, 0.f, 0.f, 0.f}, C1 = {0.f, 0.f, 0.f, 0.f}; float n = 0.f;
#pragma unroll 4
  for (int c = 0; c < 64; c++) {
    float* pc = MLC + (size_t)c * 2048 + tid * 8;
    const f32x4 l0 = *(const f32x4*)pc, l1 = *(const f32x4*)(pc + 4);
    float ln = 0.f; if (tid < 32) ln = MLN[c * 32 + tid];
    const float dec = lds[c], sc = lds[64 + c];
    *(f32x4*)pc = C0; *(f32x4*)(pc + 4) = C1; if (tid < 32) MLN[c * 32 + tid] = n;
    C0 = C0 * dec + l0 * sc; C1 = C1 * dec + l1 * sc; n = n * dec + ln * sc;
  }
  __threadfence();
  __syncthreads();
  if (tid == 0) { __hip_atomic_store(flag, 1u, __ATOMIC_RELEASE, __HIP_MEMORY_SCOPE_AGENT); }
  __syncthreads();
}
__device__ __forceinline__ void ml_p3_item(const Params& p, int l, int item, unsigned* flag, char* ldsraw) {
  if (flag) {
    if (opaque_tid() == 0) { unsigned sp = 0; while (__hip_atomic_load(flag, __ATOMIC_ACQUIRE, __HIP_MEMORY_SCOPE_AGENT) == 0u && ++sp < (1u << 24)) __builtin_amdgcn_s_sleep(2); }
    __syncthreads();
    __builtin_amdgcn_fence(__ATOMIC_ACQUIRE, "agent");
  }
  float* lds = (float*)ldsraw;
  float* Qs = lds;
  float* Ks = lds + 2112;
  float* Vs = lds + 4224;
  float* Cs = lds + 4224 + 4096;
  float* Ss = lds + 8320 + 2048;
  float* Ns = Ss + 64 * 65;
  float* Gs = Ns + 32;
  float* Bs = Gs + 64;
  float* Ms = Bs + 64;
  const bf16_t* P = (const bf16_t*)(WS(p) + OFF_P);
  bf16_t* Y = (bf16_t*)(WS(p) + OFF_Y);
  const int bh = item >> 6, c = item & 63, b = bh >> 2, h = bh & 3;
  const int tid = opaque_tid();
  const int tokb = b * S + c * 64;
  const float* cw = p.conv_w + l * 1024; const float* cb = p.conv_b + l * 256;
  const float mprev = ((const float*)(WS(p) + OFF_MLS))[(size_t)item * 4 + 2];
  {
    bf16_t* raw = (bf16_t*)(lds + 14784); float* wl = lds + 14784 + 2144;
    ml_stage_qk(P, cw, cb, raw, wl, tokb, c, h, tid);
#pragma unroll
    for (int i = 0; i < 2; i++) {
      const int ci = tid + 256 * i; const int row = ci >> 3, c8 = ci & 7;
      const u32x4 w = *(const u32x4*)(P + (size_t)(tokb + row) * PIN + C_ML + 256 + h * 64 + c8 * 8);
      *(f32x4*)(Vs + row * 64 + c8 * 8) = (f32x4){bflo(w[0]), bfhi(w[0]), bflo(w[1]), bfhi(w[1])};
      *(f32x4*)(Vs + row * 64 + c8 * 8 + 4) = (f32x4){bflo(w[2]), bfhi(w[2]), bflo(w[3]), bfhi(w[3])};
    }
    __syncthreads();
    const int t = tid >> 2, dq = tid & 3;
#pragma unroll
    for (int i = 0; i < 8; i++) {
      int d = dq * 8 + i;
      Qs[t * 33 + d] = ml_conv_lds(raw, wl, t, d) * 0.17677669529663687f;
      Ks[t * 33 + d] = ml_conv_lds(raw, wl, t, 32 + d);
    }
    const float* MLC = (const float*)(WS(p) + OFF_MLC) + (size_t)item * 2048;
    *(f32x4*)(Cs + tid * 8) = *(const f32x4*)(MLC + tid * 8); *(f32x4*)(Cs + tid * 8 + 4) = *(const f32x4*)(MLC + tid * 8 + 4);
    if (tid < 32) Ns[tid] = ((const float*)(WS(p) + OFF_MLN))[(size_t)item * 32 + tid];
  }
  if (tid < 64) {
    const int t = tid;
    const float ip = bf2f(P[(size_t)(tokb + t) * PIN + C_ML + 512 + h]) + p.i_bias[l * 4 + h];
    const float fp = bf2f(P[(size_t)(tokb + t) * PIN + C_ML + 516 + h]) + p.f_bias[l * 4 + h];
    const float lf = fminf(fp, 0.f) - log1pf(__expf(-fabsf(fp)));
    const float g = wave_scan_add_lds(Gs, t, lf);
    const float bb = ip - g;
    const float pm = wave_scan_max_lds(Ms, t, bb);
    Gs[t] = g; Bs[t] = bb; Ms[t] = fmaxf(g + mprev, g + pm);
  }
  __syncthreads();
  const int t = tid >> 2, eq = tid & 3;
  const float gt = Gs[t], mt = Ms[t];
  {
    float qv[32];
#pragma unroll
    for (int d = 0; d < 32; d++) qv[d] = Qs[t * 33 + d];
    for (int j = eq; j < 64; j += 4) {
      float sv = 0.f;
      if (j <= t) {
        float dot = 0.f;
#pragma unroll
        for (int d = 0; d < 32; d++) dot += qv[d] * Ks[j * 33 + d];
        sv = dot * __expf(gt + Bs[j] - mt);
      }
      Ss[t * 65 + j] = sv;
    }
  }
  __syncthreads();
  {
    const float iw = __expf(gt + mprev - mt);
    float num[16];
#pragma unroll
    for (int i = 0; i < 16; i++) num[i] = 0.f;
    float dn = 0.f;
    for (int d = 0; d < 32; d++) {
      const float qd = Qs[t * 33 + d];
      dn += qd * Ns[d];
#pragma unroll
      for (int i = 0; i < 16; i += 4) { const f32x4 cv = *(const f32x4*)(Cs + d * 64 + eq * 16 + i); num[i] += qd * cv[0]; num[i + 1] += qd * cv[1]; num[i + 2] += qd * cv[2]; num[i + 3] += qd * cv[3]; }
    }
    dn *= iw;
#pragma unroll
    for (int i = 0; i < 16; i++) num[i] *= iw;
    for (int j = 0; j <= t; j++) {
      const float sv = Ss[t * 65 + j];
      dn += sv;
#pragma unroll
      for (int i = 0; i < 16; i += 4) { const f32x4 vv = *(const f32x4*)(Vs + j * 64 + eq * 16 + i); num[i] += sv * vv[0]; num[i + 1] += sv * vv[1]; num[i + 2] += sv * vv[2]; num[i + 3] += sv * vv[3]; }
    }
    const float den = fmaxf(fabsf(dn), __expf(-mt));
    const float inv = 1.f / den;
    float ssq = 0.f;
#pragma unroll
    for (int i = 0; i < 16; i++) { num[i] *= inv; ssq += num[i] * num[i]; }
    ssq += __shfl_xor(ssq, 1); ssq += __shfl_xor(ssq, 2);
    const float rn = rsqrtf(ssq * (1.f / 64.f) + 1e-6f);
    const int tok = tokb + t;
    const float* on = p.ml_out_norm + l * 256 + h * 64 + eq * 16;
    const bf16_t* op = P + (size_t)tok * PIN + C_ML + 520 + h * 64 + eq * 16;
    bf16_t* yo = Y + (size_t)tok * 1024 + 768 + h * 64 + eq * 16;
#pragma unroll
    for (int i = 0; i < 16; i++) yo[i] = f2bf(num[i] * rn * on[i] * sigmoidf_(bf2f(op[i])));
  }
  __syncthreads();
}

__device__ __forceinline__ void attn_item(const Params& p, int l, int bh, int qt, char* lds) {
  const bf16_t* Q = (const bf16_t*)(WS(p) + OFF_Q); const bf16_t* KN = (const bf16_t*)(WS(p) + OFF_KN);
  const bf16_t* KPE = (const bf16_t*)(WS(p) + OFF_KPE); const bf16_t* VT = (const bf16_t*)(WS(p) + OFF_VT);
  bf16_t* Y = (bf16_t*)(WS(p) + OFF_Y);
  const int b = bh >> 2, h = bh & 3, q0 = qt * 128;
  const int tid = opaque_tid(), lane = tid & 63, wid = tid >> 6, fr = lane & 15, fq = lane >> 4;
  char* Ks = lds;
  char* Vs = lds + 49152;
  bf16x8 qf[2][6];
#pragma unroll
  for (int qs = 0; qs < 2; qs++)
#pragma unroll
    for (int kc = 0; kc < 6; kc++)
      qf[qs][kc] = *(const bf16x8*)(Q + (bh * S + q0 + wid * 32 + qs * 16 + fr) * 192 + kc * 32 + fq * 8);
  f32x4 o[2][8];
#pragma unroll
  for (int qs = 0; qs < 2; qs++)
#pragma unroll
    for (int nd = 0; nd < 8; nd++) o[qs][nd] = (f32x4){0.f, 0.f, 0.f, 0.f};
  float mrow[2] = {-1e30f, -1e30f}, lrow[2] = {0.f, 0.f};
  const int nkt = (q0 + 128) >> 6;
#define LDS3 __attribute__((address_space(3)))
  auto dmaK = [&](int kt, int bi) {
    int tt = tid; asm volatile("" : "+v"(tt));
    char* kb = Ks + bi * 24576;
#pragma unroll
    for (int i = 0; i < 6; i++) {
      const int g = i * 256 + tt; const int row = g / 24, cp = g - row * 24;
      const int c = (cp & ~7) | ((cp & 7) ^ ((row >> 1) & 7));
      const bf16_t* src_ = (c < 16) ? (KN + (bh * S + kt * 64 + row) * 128 + c * 8) : (KPE + (b * S + kt * 64 + row) * 64 + (c - 16) * 8);
      __builtin_amdgcn_global_load_lds((const unsigned*)src_, (LDS3 unsigned*)(kb + i * 4096 + tt * 16), 16, 0, 0);
    }
  };
  auto dmaV = [&](int kt) {
    int tt = tid; asm volatile("" : "+v"(tt));
#pragma unroll
    for (int i = 0; i < 4; i++) {
      const int g = i * 256 + tt; const int row = g >> 3, cp = g & 7; const int c = cp ^ ((row >> 1) & 7);
      __builtin_amdgcn_global_load_lds((const unsigned*)(VT + (bh * 128 + row) * S + kt * 64 + c * 8), (LDS3 unsigned*)(Vs + i * 4096 + tt * 16), 16, 0, 0);
    }
  };
  dmaK(0, 0); dmaV(0);
  asm volatile("s_waitcnt vmcnt(0)" ::: "memory"); __builtin_amdgcn_s_barrier(); asm volatile("" ::: "memory");
#pragma unroll 1
  for (int kt = 0; kt < nkt; kt++) {
    const bool more = (kt + 1 < nkt);
    const int k0 = kt * 64;
    const bool active = (k0 <= q0 + wid * 32 + 31);
    const char* kb = Ks + (kt & 1) * 24576;
    if (more) dmaK(kt + 1, (kt + 1) & 1);
    f32x4 sc[2][4];
    if (active) {
#pragma unroll
      for (int qs = 0; qs < 2; qs++)
#pragma unroll
        for (int ks = 0; ks < 4; ks++) sc[qs][ks] = (f32x4){0.f, 0.f, 0.f, 0.f};
#pragma unroll
      for (int ks = 0; ks < 4; ks++)
#pragma unroll
        for (int kc = 0; kc < 6; kc++) {
          const int krow_ = ks * 16 + fr, kcl_ = kc * 4 + fq;
          const bf16x8 kf = *(const bf16x8*)(kb + (krow_ * 24 + ((kcl_ & ~7) | ((kcl_ & 7) ^ ((krow_ >> 1) & 7)))) * 16);
          sc[0][ks] = __builtin_amdgcn_mfma_f32_16x16x32_bf16(kf, qf[0][kc], sc[0][ks], 0, 0, 0);
          sc[1][ks] = __builtin_amdgcn_mfma_f32_16x16x32_bf16(kf, qf[1][kc], sc[1][ks], 0, 0, 0);
          if (kc & 1) __builtin_amdgcn_sched_barrier(0);
        }
    }
    bf16x8 pf[2][2];
    if (active) {
      if (kt >= nkt - 2) {
#pragma unroll
        for (int qs = 0; qs < 2; qs++) {
          const int qrow = q0 + wid * 32 + qs * 16 + fr;
#pragma unroll
          for (int ks = 0; ks < 4; ks++)
#pragma unroll
            for (int j = 0; j < 4; j++) { const int key = k0 + ks * 16 + fq * 4 + j; if (key > qrow) sc[qs][ks][j] = -1e30f; }
        }
      }
#pragma unroll
      for (int qs = 0; qs < 2; qs++) {
        float mx = -1e30f;
#pragma unroll
        for (int ks = 0; ks < 4; ks++)
#pragma unroll
          for (int j = 0; j < 4; j++) mx = fmaxf(mx, sc[qs][ks][j]);
        mx = fmaxf(mx, __shfl_xor(mx, 16)); mx = fmaxf(mx, __shfl_xor(mx, 32));
        const float mn = fmaxf(mrow[qs], mx);
        const float alpha = __builtin_amdgcn_exp2f(mrow[qs] - mn);
        mrow[qs] = mn;
        float ps = 0.f;
#pragma unroll
        for (int ks = 0; ks < 4; ks++)
#pragma unroll
          for (int j = 0; j < 4; j++) { const float e = __builtin_amdgcn_exp2f(sc[qs][ks][j] - mn); sc[qs][ks][j] = e; ps += e; }
        lrow[qs] = lrow[qs] * alpha + ps;
#pragma unroll
        for (int nd = 0; nd < 8; nd++) o[qs][nd] *= alpha;
#pragma unroll
        for (int c2 = 0; c2 < 2; c2++) {
          u32x4 w;
          w[0] = pk2(sc[qs][2 * c2][0], sc[qs][2 * c2][1]); w[1] = pk2(sc[qs][2 * c2][2], sc[qs][2 * c2][3]);
          w[2] = pk2(sc[qs][2 * c2 + 1][0], sc[qs][2 * c2 + 1][1]); w[3] = pk2(sc[qs][2 * c2 + 1][2], sc[qs][2 * c2 + 1][3]);
          pf[qs][c2] = __builtin_bit_cast(bf16x8, w);
        }
      }
    }
    if (more) asm volatile("s_waitcnt vmcnt(6)" ::: "memory"); else asm volatile("s_waitcnt vmcnt(0)" ::: "memory");
    __builtin_amdgcn_s_barrier(); asm volatile("" ::: "memory");
    if (active) {
#pragma unroll
      for (int nd = 0; nd < 8; nd++)
#pragma unroll
        for (int c2 = 0; c2 < 2; c2++) {
          const int vrow_ = nd * 16 + fr;
          const bf16x8 vf = *(const bf16x8*)(Vs + (vrow_ * 8 + ((c2 * 4 + fq) ^ ((vrow_ >> 1) & 7))) * 16);
          o[0][nd] = __builtin_amdgcn_mfma_f32_16x16x32_bf16(vf, pf[0][c2], o[0][nd], 0, 0, 0);
          o[1][nd] = __builtin_amdgcn_mfma_f32_16x16x32_bf16(vf, pf[1][c2], o[1][nd], 0, 0, 0);
          if (c2 == 1) __builtin_amdgcn_sched_barrier(0);
        }
    }
    asm volatile("s_waitcnt vmcnt(0) lgkmcnt(0)" ::: "memory"); __builtin_amdgcn_s_barrier(); asm volatile("" ::: "memory");
    if (more) dmaV(kt + 1);
  }
  const float* on = p.mla_out_norm + l * 512 + h * 128;
#pragma unroll
  for (int qs = 0; qs < 2; qs++) {
    float lt = lrow[qs]; lt += __shfl_xor(lt, 16); lt += __shfl_xor(lt, 32);
    const float inv = 1.f / lt;
    float ssq = 0.f;
#pragma unroll
    for (int nd = 0; nd < 8; nd++) { o[qs][nd] *= inv; ssq += o[qs][nd][0] * o[qs][nd][0] + o[qs][nd][1] * o[qs][nd][1] + o[qs][nd][2] * o[qs][nd][2] + o[qs][nd][3] * o[qs][nd][3]; }
    ssq += __shfl_xor(ssq, 16); ssq += __shfl_xor(ssq, 32);
    const float rn = rsqrtf(ssq * (1.f / 128.f) + 1e-6f);
    const int tok = b * S + q0 + wid * 32 + qs * 16 + fr;
    bf16_t* yo = Y + (size_t)tok * 1024 + h * 128;
#pragma unroll
    for (int nd = 0; nd < 8; nd++) {
      const int dv = nd * 16 + fq * 4;
      const f32x4 g = *(const f32x4*)(on + dv);
      f32x4 v = o[qs][nd] * rn * g;
      u32x2 w; w[0] = pk2(v[0], v[1]); w[1] = pk2(v[2], v[3]);
      *(u32x2*)(yo + dv) = w;
    }
  }
}

__device__ __forceinline__ void final_norm_rows(const Params& p) {
  const int tid_ = opaque_tid(); const int lane = tid_ & 63, wid = tid_ >> 6;
  for (int row0 = (blockIdx.x * 4 + wid) * 4; row0 < T; row0 += gridDim.x * 16) {
    f32x4 v[4][4];
#pragma unroll
    for (int r = 0; r < 4; r++)
#pragma unroll
      for (int i = 0; i < 4; i++) v[r][i] = *(const f32x4*)(p.out + (size_t)(row0 + r) * DM + i * 256 + lane * 4);
#pragma unroll
    for (int r = 0; r < 4; r++) {
      float ss = 0.f;
#pragma unroll
      for (int i = 0; i < 4; i++) ss += v[r][i][0] * v[r][i][0] + v[r][i][1] * v[r][i][1] + v[r][i][2] * v[r][i][2] + v[r][i][3] * v[r][i][3];
      ss = wave_sum(ss);
      const float rn = rsqrtf(ss * (1.f / 1024.f) + 1e-6f);
#pragma unroll
      for (int i = 0; i < 4; i++) { const f32x4 g = *(const f32x4*)(p.final_norm + i * 256 + lane * 4); *(f32x4*)(p.out + (size_t)(row0 + r) * DM + i * 256 + lane * 4) = v[r][i] * rn * g; }
    }
  }
}

constexpr int N_PHASES = 16;
#ifndef ONLY
#define ONLY -1
#endif
#define EN(k) (ONLY < 0 || ONLY == (k))
__device__ __forceinline__ void run_phase(const Params& p, int ph, char* lds, int mode) {
  const int G = gridDim.x, B = blockIdx.x;
  if (ph == 0) {
    {
      const int tid = opaque_tid(), lane = tid & 63, wv = tid >> 6;
      bf16_t* xb = (bf16_t*)(WS(p) + OFF_XB); float* rss = (float*)(WS(p) + OFF_RSS);
      for (int row0 = (B * 4 + wv) * 4; row0 < T; row0 += G * 16) {
        f32x4 a[4][4];
#pragma unroll
        for (int r = 0; r < 4; r++)
#pragma unroll
          for (int i = 0; i < 4; i++) a[r][i] = *(const f32x4*)(p.x + (size_t)(row0 + r) * DM + i * 256 + lane * 4);
#pragma unroll
        for (int r = 0; r < 4; r++) {
          float ss = 0.f;
#pragma unroll
          for (int i = 0; i < 4; i++) {
            u32x2 w; w[0] = pk2(a[r][i][0], a[r][i][1]); w[1] = pk2(a[r][i][2], a[r][i][3]);
            *(u32x2*)(xb + (size_t)(row0 + r) * DM + i * 256 + lane * 4) = w;
            const float b0 = bflo(w[0]), b1 = bfhi(w[0]), b2 = bflo(w[1]), b3 = bfhi(w[1]);
            ss += b0 * b0 + b1 * b1 + b2 * b2 + b3 * b3;
          }
          ss = wave_sum(ss);
          if (lane == 0) rss[row0 + r] = ss;
        }
      }
    }
    { float* z = (float*)(WS(p) + OFF_RSS) + 2 * T; for (int i = B * NTHREADS + opaque_tid(); i < 2 * T; i += G * NTHREADS) z[i] = 0.f; }
    for (int it = B; it < N_CONV_MIX; it += G) conv_mixer(p, 0, it, lds);
    return;
  }
  if (ph == 15) { final_norm_rows(p); return; }
  const int l = (ph - 1) / 7, sp = (ph - 1) % 7;
  const float* xin = (l == 0) ? p.x : p.out;
  switch (sp) {
    case 0: {
      float* z = (float*)(WS(p) + OFF_RSS) + T;
      for (int i = B * NTHREADS + opaque_tid(); i < T; i += G * NTHREADS) z[i] = 0.f;
      for (int it = B; it < 128 * 18; it += G) if (EN(1)) gemm_A(p, it, lds);
    } break;
    case 1: {
      if (l == 0) { float* z = (float*)(WS(p) + OFF_RSS); for (int i = B * NTHREADS + opaque_tid(); i < T; i += G * NTHREADS) z[i] = 0.f; }
      const int n = 768 + 1024 + 1024 + 1024;
      for (int it = B; it < n; it += G) {
        if (it < 768) { if (EN(10) && (mode == 0 || mode == 1)) gemm_Q(p, it, lds); }
        else if (it < 1792) { if (EN(11) && (mode == 0 || mode == 2)) gemm_KV(p, it - 768, lds); }
        else if (it < 2816) { if (EN(12) && (mode == 0 || mode == 3)) rwkv_prep_item(p, l, it - 1792, lds); }
        else { if (EN(13) && (mode == 0 || mode == 4)) ml_p1_item(p, l, it - 2816, lds); }
      }
    } break;
    case 2: {
      unsigned* ctr = (unsigned*)(WS(p) + OFF_CTRL) + (mode ? 8 + mode : l);
      int* sh = (int*)(lds + 74240);
      for (;;) {
        __syncthreads();
        if (opaque_tid() == 0) *sh = (int)atomicAdd(ctr, 1u);
        __syncthreads();
        int it = *sh;
        if (mode == 1) { if (it >= 192) break; }
        else if (mode == 2) { if (it >= 512) break; it += 208; }
        const int ntot = 192 + 16 + 512 + 1024 + N_CONV_FFN + (l == 0 ? N_CONV_MIX : 0);
        if (it >= ntot) break;
        unsigned* flags = (unsigned*)(WS(p) + OFF_CTRL) + 16 + l * 16;
        if (it < 192) { if (EN(20)) rwkv_scan2_item(p, it, lds); }
        else if (it < 208) { if (EN(21)) ml_p2_item(p, it - 192, flags + (it - 192), lds); }
        else if (it < 720) { const int a = it - 208; if (EN(22)) attn_item(p, l, a & 15, 31 - (a >> 4), lds); }
        else if (mode != 0) { }
        else if (it < 1744) { if (EN(30)) ml_p3_item(p, l, it - 720, flags + ((it - 720) >> 6), lds); }
        else if (it < 1744 + N_CONV_FFN) { if (EN(41)) conv_ffn(p, l, it - 1744, lds); }
        else conv_mixer(p, 1, it - 1744 - N_CONV_FFN, lds);
      }
    } break;
    case 3: for (int it = B; it < 1024; it += G) { if (EN(31)) rwkv_fin_item(p, l, it, lds); } break;
    case 4: {
      { float* z = (float*)(WS(p) + OFF_RSS) + 2 * T; for (int i = B * NTHREADS + opaque_tid(); i < 2 * T; i += G * NTHREADS) z[i] = 0.f; }
      const bf16_t* wo = (const bf16_t*)(WS(p) + ((l & 1) ? OFF_WOUT2 : OFF_WOUT));
      for (int it = B; it < 1024; it += G) { if (EN(40)) gemm_RES((const bf16_t*)(WS(p) + OFF_Y), 1024, wo, xin, p.out, (bf16_t*)(WS(p) + OFF_XB), (float*)(WS(p) + OFF_RSS) + T, it, lds); __syncthreads(); }
    } break;
    case 5: for (int it = B; it < 128 * 44; it += G) { if (mode == 1) gemm_GU_probe(p, it, lds); else if (EN(50)) gemm_GU(p, it, lds); } break;
    case 6: {
      for (int it = B; it < 1024; it += G) { if (EN(60)) gemm_RES((const bf16_t*)(WS(p) + OFF_U), DFF, (const bf16_t*)(WS(p) + OFF_WDN), p.out, p.out, (bf16_t*)(WS(p) + OFF_XB), (float*)(WS(p) + OFF_RSS), it, lds); __syncthreads(); }
    } break;
  }
}

__global__ void __launch_bounds__(NTHREADS, 2) mk_fwd(Params p) {
  extern __shared__ __attribute__((aligned(16))) char lds[];
  if (p.phase_hi > N_PHASES) cg::this_grid().sync();
  volatile LAS unsigned* st = (volatile LAS unsigned*)(lds + 74256);
  if (opaque_tid() == 0) { st[0] = 0u; st[1] = 0u; }
  __syncthreads();
  XcdBarrier xb = xcd_barrier_post((unsigned*)(WS(p) + OFF_BAR), st);
  const int nsteps = (p.phase_hi - p.phase_lo) + (PROBE_PH >= 0 ? 1 : 0);
  for (int i = 0; i < nsteps; i++) {
    int ph = p.phase_lo + i, mode = 0;
    if (PROBE_PH >= 0 && ph > PROBE_PH) { ph -= 1; if (ph == PROBE_PH) mode = PROBE_MODE; }
    if (i > 0) xcd_barrier(xb);
    run_phase(p, ph, lds, mode);
  }
}

extern "C" void kernel_launch(void* const* d_in, const int* in_sizes, int n_in, void* d_out, int out_size, void* d_ws, size_t ws_size, hipStream_t stream) {
  Params p{};
  p.x = (const float*)d_in[0]; p.pos = (const int*)d_in[1];
  p.mix_norm = (const float*)d_in[2]; p.w_in = (const float*)d_in[3]; p.q_norm = (const float*)d_in[4]; p.w_uq = (const float*)d_in[5];
  p.kv_norm = (const float*)d_in[6]; p.w_ukv = (const float*)d_in[7]; p.mla_out_norm = (const float*)d_in[8];
  p.mu = (const float*)d_in[9]; p.w0 = (const float*)d_in[10]; p.w2 = (const float*)d_in[11]; p.a0 = (const float*)d_in[12]; p.a2 = (const float*)d_in[13];
  p.g2 = (const float*)d_in[14]; p.k_k = (const float*)d_in[15]; p.k_a = (const float*)d_in[16]; p.r_k = (const float*)d_in[17];
  p.ln_w = (const float*)d_in[18]; p.ln_b = (const float*)d_in[19];
  p.conv_w = (const float*)d_in[20]; p.conv_b = (const float*)d_in[21]; p.i_bias = (const float*)d_in[22]; p.f_bias = (const float*)d_in[23]; p.ml_out_norm = (const float*)d_in[24];
  p.w_out = (const float*)d_in[25]; p.ffn_norm = (const float*)d_in[26]; p.w_gate = (const float*)d_in[27]; p.w_up = (const float*)d_in[28]; p.w_down = (const float*)d_in[29];
  p.final_norm = (const float*)d_in[30];
  p.out = (float*)d_out; p.ws = (unsigned char*)d_ws;
  static int grid_blocks = 0;
  if (!grid_blocks) {
    hipFuncSetAttribute((const void*)mk_fwd, hipFuncAttributeMaxDynamicSharedMemorySize, LDS_BYTES);
    int dev = 0, cus = 0, per_cu = 0;
    hipGetDevice(&dev);
    hipDeviceGetAttribute(&cus, hipDeviceAttributeMultiprocessorCount, dev);
    hipOccupancyMaxActiveBlocksPerMultiprocessor(&per_cu, mk_fwd, NTHREADS, LDS_BYTES);
    if (per_cu < 1) per_cu = 1;
    if (per_cu > 2) per_cu = 2;
    grid_blocks = cus * per_cu;
  }
  hipMemsetAsync(d_ws, 0, CTRL_BYTES, stream);
#if MK_ONE_LAUNCH
  p.phase_lo = 0; p.phase_hi = N_PHASES;
  void* args[] = {&p};
  hipError_t e = hipLaunchCooperativeKernel((const void*)mk_fwd, dim3(grid_blocks), dim3(NTHREADS), args, LDS_BYTES, stream);
  if (e != hipSuccess) fprintf(stderr, "cooperative launch failed: %s (grid %d)\n", hipGetErrorString(e), grid_blocks);
#else
  for (int ph = 0; ph < N_PHASES; ph++) {
    p.phase_lo = ph; p.phase_hi = ph + 1;
    hipLaunchKernelGGL(mk_fwd, dim3(grid_blocks), dim3(NTHREADS), LDS_BYTES, stream, p);
  }
#endif
}
```

```cpp
#include <hip/hip_runtime.h>
#include <hip/hip_cooperative_groups.h>
#include <cstdint>
#include <cstdio>
namespace cg = cooperative_groups;

#ifndef PROBE_PH
#define PROBE_PH -1
#endif
#ifndef PROBE_VAR
#define PROBE_VAR 0
#endif
#ifndef PROBE_MODE
#define PROBE_MODE 0
#endif
#ifndef MK_ONE_LAUNCH
#define MK_ONE_LAUNCH 1
#endif

typedef unsigned short bf16_t;
typedef short bf16x8 __attribute__((ext_vector_type(8)));
typedef float f32x4 __attribute__((ext_vector_type(4)));
typedef float f32x2 __attribute__((ext_vector_type(2)));
typedef unsigned u32x4 __attribute__((ext_vector_type(4)));
typedef unsigned u32x2 __attribute__((ext_vector_type(2)));

constexpr int NB = 4, S = 4096, DM = 1024, T = NB * S;
constexpr int PIN = 2248, DFF = 2816;
constexpr int C_CQ = 0, C_CKV = 256, C_KPE = 512, C_RW = 576, C_ML = 1472;
constexpr int NTHREADS = 256;
constexpr int LDS_BYTES = 74240 + 64;

constexpr size_t OFF_CTRL = 0;
constexpr size_t OFF_BAR  = 4096;
constexpr size_t CTRL_BYTES = 32768;
constexpr size_t OFF_WIN  = CTRL_BYTES;
constexpr size_t OFF_WUQ  = OFF_WIN  + (size_t)2304 * 1024 * 2;
constexpr size_t OFF_WUKV = OFF_WUQ  + (size_t)768 * 256 * 2;
constexpr size_t OFF_WOUT = OFF_WUKV + (size_t)1024 * 256 * 2;
constexpr size_t OFF_P    = OFF_WOUT + (size_t)1024 * 1024 * 2;
constexpr size_t OFF_Q    = OFF_P    + (size_t)T * PIN * 2;
constexpr size_t OFF_KN   = OFF_Q    + (size_t)T * 768 * 2;
constexpr size_t OFF_KPE  = OFF_KN   + (size_t)T * 512 * 2;
constexpr size_t OFF_VT   = OFF_KPE  + (size_t)T * 64 * 2;
constexpr size_t OFF_RW   = OFF_VT   + (size_t)T * 512 * 2;
constexpr size_t OFF_RB   = OFF_RW   + (size_t)T * 256 * 4;
constexpr size_t OFF_RC   = OFF_RB   + (size_t)T * 4 * 320 * 2;
constexpr size_t OFF_Y    = OFF_RC   + (size_t)T * 4 * 4 * 4;
constexpr size_t OFF_MLC  = OFF_Y    + (size_t)T * 1024 * 2;
constexpr size_t OFF_MLN  = OFF_MLC  + (size_t)1024 * 2048 * 4;
constexpr size_t OFF_MLS  = OFF_MLN  + (size_t)1024 * 32 * 4;
constexpr size_t OFF_WGU  = OFF_MLS  + (size_t)1024 * 4 * 4;
constexpr size_t OFF_WDN  = OFF_WGU  + (size_t)5632 * 1024 * 2;
constexpr size_t OFF_WOUT2 = OFF_WDN + (size_t)1024 * 2816 * 2;
constexpr size_t OFF_Z    = OFF_WOUT2 + (size_t)1024 * 1024 * 2;
constexpr size_t OFF_SF   = OFF_Z    + (size_t)16 * 2048 * 64 * 2;
constexpr size_t OFF_RSS  = OFF_SF   + (size_t)16 * 64 * 64 * 4;
constexpr size_t WS_TOTAL = OFF_RSS  + (size_t)4 * T * 4;
constexpr size_t OFF_XB   = OFF_KN;
static_assert((size_t)T * DM * 2 <= (OFF_RW - OFF_KN), "XB overlay");
constexpr size_t OFF_U    = OFF_P;
static_assert((size_t)T * DFF * 2 <= (OFF_KN - OFF_P), "U overlay");
static_assert(WS_TOTAL <= ((size_t)256 << 20), "workspace");

struct Params {
  const float* x; const int* pos;
  const float *mix_norm, *w_in, *q_norm, *w_uq, *kv_norm, *w_ukv, *mla_out_norm;
  const float *mu, *w0, *w2, *a0, *a2, *g2, *k_k, *k_a, *r_k, *ln_w, *ln_b;
  const float *conv_w, *conv_b, *i_bias, *f_bias, *ml_out_norm;
  const float *w_out, *ffn_norm, *w_gate, *w_up, *w_down, *final_norm;
  float* out; unsigned char* ws;
  int phase_lo, phase_hi;
};

__device__ __forceinline__ unsigned char* WS(const Params& p) { unsigned z = 0; asm volatile("" : "+s"(z)); return p.ws + z; }
__device__ const float c_inv_freq[32] = {
1.000000000e+00f, 7.498942093e-01f, 5.623413252e-01f, 4.216965034e-01f, 3.162277660e-01f, 2.371373706e-01f, 1.778279410e-01f, 1.333521432e-01f, 1.000000000e-01f, 7.498942093e-02f, 5.623413252e-02f, 4.216965034e-02f, 3.162277660e-02f, 2.371373706e-02f, 1.778279410e-02f, 1.333521432e-02f, 1.000000000e-02f, 7.498942093e-03f, 5.623413252e-03f, 4.216965034e-03f, 3.162277660e-03f, 2.371373706e-03f, 1.778279410e-03f, 1.333521432e-03f, 1.000000000e-03f, 7.498942093e-04f, 5.623413252e-04f, 4.216965034e-04f, 3.162277660e-04f, 2.371373706e-04f, 1.778279410e-04f, 1.333521432e-04f};

__device__ __forceinline__ int opaque_tid() { int t = threadIdx.x; asm volatile("" : "+v"(t)); return t; }
__device__ __forceinline__ float bf2f(unsigned short b) { return __uint_as_float(((unsigned)b) << 16); }
__device__ __forceinline__ unsigned short f2bf(float f) { unsigned r; asm("v_cvt_pk_bf16_f32 %0, %1, %1" : "=v"(r) : "v"(f)); return (unsigned short)(r & 0xffffu); }
__device__ __forceinline__ unsigned pk2(float lo, float hi) { unsigned r; asm("v_cvt_pk_bf16_f32 %0, %1, %2" : "=v"(r) : "v"(lo), "v"(hi)); return r; }
__device__ __forceinline__ float bflo(unsigned u) { return __uint_as_float(u << 16); }
__device__ __forceinline__ float bfhi(unsigned u) { return __uint_as_float(u & 0xffff0000u); }
__device__ __forceinline__ float wave_sum(float v);
__device__ __forceinline__ float sigmoidf_(float x) { return __builtin_amdgcn_rcpf(1.0f + __expf(-x)); }
__device__ __forceinline__ float fma_s(float a, float b, float c) { float d; asm("v_fma_f32 %0, %1, %2, %3" : "=v"(d) : "v"(a), "v"(b), "v"(c)); return d; }
__device__ __forceinline__ float fnma_s(float a, float b, float c) { float d; asm("v_fma_f32 %0, -%1, %2, %3" : "=v"(d) : "v"(a), "v"(b), "v"(c)); return d; }
__device__ __forceinline__ float mul_s(float a, float b) { float d; asm("v_mul_f32 %0, %1, %2" : "=v"(d) : "v"(a), "v"(b)); return d; }
__device__ __forceinline__ float add_s(float a, float b) { float d; asm("v_add_f32 %0, %1, %2" : "=v"(d) : "v"(a), "v"(b)); return d; }
__device__ __forceinline__ float sel_eq(float keep, float v, int a, int b) { asm("v_cmp_eq_u32 vcc, %1, %2\n\tv_cndmask_b32 %0, %0, %3, vcc" : "+v"(keep) : "v"(a), "v"(b), "v"(v) : "vcc"); return keep; }
template <int CTRL> __device__ __forceinline__ float dppf(float v) {
  return __int_as_float(__builtin_amdgcn_update_dpp(0, __float_as_int(v), CTRL, 0xf, 0xf, true));
}
__device__ __forceinline__ float row16_sum(float x) {
  x += dppf<0xB1>(x); x += dppf<0x4E>(x); x += dppf<0x124>(x); x += dppf<0x128>(x);
  return x;
}
__device__ __forceinline__ float wave_sum(float v) {
  v = row16_sum(v); v += __shfl_xor(v, 16); v += __shfl_xor(v, 32);
  return v;
}
__device__ __forceinline__ void rope_cs(int pos, int i, float& c, float& s) {
  double rev = (double)pos * (double)c_inv_freq[i] * 0.15915494309189535;
  rev -= rint(rev);
  float r = (float)rev;
  s = __builtin_amdgcn_sinf(r); c = __builtin_amdgcn_cosf(r);
}


#define XB_TMO      128
#define XB_XCNT(j)  (256  + 64 * (j))
#define XB_XSUB(j)  (1280 + 64 * (j))
#define XB_XGEN(j)  (2304 + 64 * (j))
#define XB_TOP      3328
#define XB_TOPGEN   3392
#define XCD_BAR_WORDS 3456
#define XB_SPIN_CAP (1u << 20)
#define LAS __attribute__((address_space(3)))
__device__ __forceinline__ unsigned xb_ld(unsigned* p)              { return __hip_atomic_load(p, __ATOMIC_RELAXED, __HIP_MEMORY_SCOPE_AGENT); }
__device__ __forceinline__ unsigned xb_add(unsigned* p, unsigned v) { return __hip_atomic_fetch_add(p, v, __ATOMIC_RELAXED, __HIP_MEMORY_SCOPE_AGENT); }
__device__ __forceinline__ unsigned xb_xcc_id() { return (unsigned)__builtin_amdgcn_s_getreg((3 << 11) | 20) & 0xFu; }
#define XB_SPIN(cond, bar) do { unsigned _sp = 0; while (cond) { __builtin_amdgcn_s_sleep(1); \
    if ((++_sp & 255u) == 0u) { if (xb_ld(&(bar)[XB_TMO])) break; if (_sp > XB_SPIN_CAP) { atomicAdd(&(bar)[XB_TMO], 1u); break; } } } } while (0)
struct XcdBarrier { unsigned* bar; unsigned x; volatile LAS unsigned* st; };
__device__ __forceinline__ XcdBarrier xcd_barrier_post(unsigned* bar, volatile LAS unsigned* st) {
    XcdBarrier b; b.bar = bar; b.x = xb_xcc_id(); b.st = st;
    if (opaque_tid() == 0) (void)xb_add(&bar[XB_XCNT(b.x)], 1u);
    return b;
}
__device__ __forceinline__ void xcd_barrier_complete(unsigned* bar, unsigned x, unsigned& nloc, unsigned& nx) {
    const unsigned G = gridDim.x * gridDim.y * gridDim.z;
    unsigned sum, cnt, mine, sp = 0u;
    for (;;) {
        sum = 0u; cnt = 0u; mine = 0u;
#pragma unroll
        for (unsigned j = 0; j < 16; ++j) { const unsigned c = xb_ld(&bar[XB_XCNT(j)]); sum += c; cnt += (c > 0u) ? 1u : 0u; mine = (j == x) ? c : mine; }
        if (sum == G) break;
        __builtin_amdgcn_s_sleep(1);
        if ((++sp & 255u) == 0u) { if (xb_ld(&bar[XB_TMO])) break; if (sp > XB_SPIN_CAP) { atomicAdd(&bar[XB_TMO], 1u); break; } }
    }
    nloc = mine > 0u ? mine : 1u; nx = cnt > 0u ? cnt : 1u;
}
__device__ __forceinline__ void xcd_barrier(const XcdBarrier& b) {
    asm volatile("s_waitcnt vmcnt(0)" ::: "memory");
    __syncthreads();
    if (opaque_tid() == 0) {
        unsigned* bar = b.bar;
        __builtin_amdgcn_s_waitcnt(0);
        unsigned nloc = b.st[0], nx = b.st[1];
        if (nloc == 0u) { xcd_barrier_complete(bar, b.x, nloc, nx); b.st[0] = nloc; b.st[1] = nx; }
        const unsigned old = xb_add(&bar[XB_XSUB(b.x)], 1u);
        const unsigned gen = old / nloc;
        if (old + 1u == (gen + 1u) * nloc) {
            __builtin_amdgcn_fence(__ATOMIC_RELEASE, "agent");
            asm volatile("s_waitcnt vmcnt(0)" ::: "memory");
            const unsigned og = xb_add(&bar[XB_TOP], 1u);
            const unsigned tg = og / nx;
            if (og + 1u == (tg + 1u) * nx) xb_add(&bar[XB_TOPGEN], 1u);
            else XB_SPIN(xb_ld(&bar[XB_TOPGEN]) == tg, bar);
            __builtin_amdgcn_fence(__ATOMIC_ACQUIRE, "agent");
            xb_add(&bar[XB_XGEN(b.x)], 1u);
            asm volatile("s_waitcnt vmcnt(0)" ::: "memory");
        } else {
            XB_SPIN(xb_ld(&bar[XB_XGEN(b.x)]) == gen, bar);
            __builtin_amdgcn_fence(__ATOMIC_ACQUIRE, "agent");
            asm volatile("s_waitcnt vmcnt(0)" ::: "memory");
        }
    }
    __syncthreads();
}

__device__ __forceinline__ void conv_tile(const float* __restrict__ s0, const float* __restrict__ s1, int mode, int K, int Nsrc,
                          const float* __restrict__ gain, bf16_t* __restrict__ dst, int kt, int nt, char* ldsraw) {
  float* lds = (float*)ldsraw;
  const int tid = opaque_tid();
  const float* gp = gain ? gain : s0;
  float vals[16], gv[16];
#pragma unroll
  for (int i = 0; i < 16; i++) {
    const int idx = tid + 256 * i; const int kk = idx >> 6, nn = idx & 63; const int n = nt * 64 + nn, k = kt * 64 + kk;
    const float* sp; int col;
    if (mode == 0) { sp = s0; col = (n < Nsrc) ? n : (Nsrc - 1); }
    else { const int g = n >> 5, r = n & 31; col = g * 16 + (r & 15); sp = (r < 16) ? s0 : s1; }
    vals[i] = __builtin_nontemporal_load(sp + (size_t)k * Nsrc + col);
    gv[i] = gp[k];
  }
#pragma unroll
  for (int i = 0; i < 16; i++) {
    const int idx = tid + 256 * i; const int kk = idx >> 6, nn = idx & 63; const int n = nt * 64 + nn;
    float v = gain ? vals[i] * gv[i] : vals[i];
    if (mode == 0 && n >= Nsrc) v = 0.f;
    lds[kk * 65 + nn] = v;
  }
  __syncthreads();
#pragma unroll 4
  for (int i = 0; i < 16; i++) {
    int idx = tid + 256 * i; int nn = idx >> 6, kk = idx & 63;
    dst[(size_t)(nt * 64 + nn) * K + kt * 64 + kk] = f2bf(lds[kk * 65 + nn]);
  }
  __syncthreads();
}
constexpr int N_CONV_MIX = 576 + 48 + 64 + 256;
constexpr int N_CONV_FFN = 1408 + 704;
__device__ __forceinline__ void conv_mixer(const Params& p, int l, int item, char* lds) {
  unsigned char* ws = WS(p);
  if (item < 576) conv_tile(p.w_in + (size_t)l * 1024 * PIN, nullptr, 0, 1024, PIN, p.mix_norm + l * 1024, (bf16_t*)(ws + OFF_WIN), item / 36, item % 36, lds);
  else if (item < 624) { item -= 576; conv_tile(p.w_uq + (size_t)l * 256 * 768, nullptr, 0, 256, 768, p.q_norm + l * 256, (bf16_t*)(ws + OFF_WUQ), item / 12, item % 12, lds); }
  else if (item < 688) { item -= 624; conv_tile(p.w_ukv + (size_t)l * 256 * 1024, nullptr, 0, 256, 1024, p.kv_norm + l * 256, (bf16_t*)(ws + OFF_WUKV), item / 16, item % 16, lds); }
  else { item -= 688; conv_tile(p.w_out + (size_t)l * 1024 * 1024, nullptr, 0, 1024, 1024, nullptr, (bf16_t*)(ws + ((l & 1) ? OFF_WOUT2 : OFF_WOUT)), item / 16, item % 16, lds); }
}
__device__ __forceinline__ void conv_ffn(const Params& p, int l, int item, char* lds) {
  unsigned char* ws = WS(p);
  if (item < 1408) conv_tile(p.w_gate + (size_t)l * 1024 * DFF, p.w_up + (size_t)l * 1024 * DFF, 1, 1024, DFF, p.ffn_norm + l * 1024, (bf16_t*)(ws + OFF_WGU), item / 88, item % 88, lds);
  else { item -= 1408; conv_tile(p.w_down + (size_t)l * DFF * 1024, nullptr, 0, DFF, 1024, nullptr, (bf16_t*)(ws + OFF_WDN), item / 16, item % 16, lds); }
}

template <bool AF32, bool ROWSS>
__device__ __forceinline__ void gemm_mainloop(const void* __restrict__ Ap, int lda, const bf16_t* __restrict__ Bt, int K,
                                              int m0, int n0, f32x4 (&acc)[4][4], char* lds, float eps) {
  const int tid = opaque_tid(), lane = tid & 63, wid = tid >> 6, wr = wid >> 1, wc = wid & 1, fr = lane & 15, fq = lane >> 4;
  const int lr = tid >> 3, lc = tid & 7;
  u32x4 ra[4], rb[4]; f32x4 fa[4][2];
  float ss[4] = {0.f, 0.f, 0.f, 0.f};
#pragma unroll
  for (int m = 0; m < 4; m++)
#pragma unroll
    for (int n = 0; n < 4; n++) acc[m][n] = (f32x4){0.f, 0.f, 0.f, 0.f};
  const int nk = K >> 6;
  auto gload = [&](int kt) {
#pragma unroll
    for (int i = 0; i < 4; i++) {
      const int row = lr + 32 * i;
      if (AF32) { const float* q = (const float*)Ap + (size_t)(m0 + row) * lda + kt * 64 + lc * 8; fa[i][0] = *(const f32x4*)q; fa[i][1] = *(const f32x4*)(q + 4); }
      else { const bf16_t* q = (const bf16_t*)Ap + (size_t)(m0 + row) * lda + kt * 64 + lc * 8; ra[i] = *(const u32x4*)q; }
      rb[i] = *(const u32x4*)(Bt + (size_t)(n0 + row) * K + kt * 64 + lc * 8);
    }
  };
  auto lstore = [&](int st) {
    char* la = lds + st * 18432; char* lb = lds + 36864 + st * 18432;
#pragma unroll
    for (int i = 0; i < 4; i++) {
      const int row = lr + 32 * i;
      u32x4 w;
      if (AF32) {
        f32x4 a = fa[i][0], b = fa[i][1];
        if (ROWSS) ss[i] += a[0] * a[0] + a[1] * a[1] + a[2] * a[2] + a[3] * a[3] + b[0] * b[0] + b[1] * b[1] + b[2] * b[2] + b[3] * b[3];
        w[0] = pk2(a[0], a[1]); w[1] = pk2(a[2], a[3]); w[2] = pk2(b[0], b[1]); w[3] = pk2(b[2], b[3]);
      } else {
        w = ra[i];
        if (ROWSS) {
#pragma unroll
          for (int e = 0; e < 4; e++) { float lo = bflo(w[e]), hi = bfhi(w[e]); ss[i] += lo * lo + hi * hi; }
        }
      }
      *(u32x4*)(la + (row * 72 + lc * 8) * 2) = w;
      *(u32x4*)(lb + (row * 72 + lc * 8) * 2) = rb[i];
    }
  };
  gload(0); lstore(0); __syncthreads();
  for (int kt = 0; kt < nk; kt++) {
    const int st = kt & 1;
    if (kt + 1 < nk) gload(kt + 1);
    const char* la = lds + st * 18432; const char* lb = lds + 36864 + st * 18432;
    {
      bf16x8 af[2][4], bfv[2][4];
#pragma unroll
      for (int kc = 0; kc < 2; kc++) {
#pragma unroll
        for (int m = 0; m < 4; m++) af[kc][m] = *(const bf16x8*)(la + ((wr * 64 + m * 16 + fr) * 72 + kc * 32 + fq * 8) * 2);
#pragma unroll
        for (int n = 0; n < 4; n++) bfv[kc][n] = *(const bf16x8*)(lb + ((wc * 64 + n * 16 + fr) * 72 + kc * 32 + fq * 8) * 2);
      }
      __builtin_amdgcn_sched_barrier(0);
#pragma unroll
      for (int kc = 0; kc < 2; kc++)
#pragma unroll
        for (int m = 0; m < 4; m++)
#pragma unroll
          for (int n = 0; n < 4; n++) acc[m][n] = __builtin_amdgcn_mfma_f32_16x16x32_bf16(bfv[kc][n], af[kc][m], acc[m][n], 0, 0, 0);
      __builtin_amdgcn_sched_barrier(0);
    }
    if (kt + 1 < nk) lstore(st ^ 1);
    __syncthreads();
  }
  if (ROWSS) {
    float* rs = (float*)(lds + 73728);
#pragma unroll
    for (int i = 0; i < 4; i++) {
      float v = ss[i]; v += __shfl_xor(v, 1); v += __shfl_xor(v, 2); v += __shfl_xor(v, 4);
      if (lc == 0) rs[lr + 32 * i] = rsqrtf(v / (float)K + eps);
    }
    __syncthreads();
  }
}
template <bool ROWSS>
__device__ __forceinline__ void gemm_mainloop_b(const bf16_t* __restrict__ Ap, int lda, const bf16_t* __restrict__ Bt, int K,
                                                int m0, int n0, f32x4 (&acc)[4][4], char* lds, float eps) {
  const int tid = opaque_tid(), lane = tid & 63, wid = tid >> 6, wr = wid >> 1, wc = wid & 1, fr = lane & 15, fq = lane >> 4;
  const int lr = tid >> 3, lc = tid & 7;
  u32x4 ra0[4], rb0[4];
  float ss[4] = {0.f, 0.f, 0.f, 0.f};
#pragma unroll
  for (int m = 0; m < 4; m++)
#pragma unroll
    for (int n = 0; n < 4; n++) acc[m][n] = (f32x4){0.f, 0.f, 0.f, 0.f};
  const int nk = K >> 6;
  const bf16_t* pa = Ap + (size_t)(m0 + lr) * lda + lc * 8;
  const bf16_t* pb = Bt + (size_t)(n0 + lr) * K + lc * 8;
#define GL(ra_, rb_, kt_) { _Pragma("unroll") for (int i = 0; i < 4; i++) { ra_[i] = *(const u32x4*)(pa + (size_t)(32 * i) * lda + (kt_) * 64); rb_[i] = *(const u32x4*)(pb + (size_t)(32 * i) * K + (kt_) * 64); } }
#define LS(ra_, rb_, st_) { char* la_ = lds + (st_) * 18432; char* lb_ = lds + 36864 + (st_) * 18432; _Pragma("unroll") for (int i = 0; i < 4; i++) { const int row = lr + 32 * i; u32x4 w = ra_[i]; \
      if (ROWSS) { _Pragma("unroll") for (int e = 0; e < 4; e++) { float lo = bflo(w[e]), hi = bfhi(w[e]); ss[i] += lo * lo + hi * hi; } } \
      *(u32x4*)(la_ + (row * 72 + lc * 8) * 2) = w; *(u32x4*)(lb_ + (row * 72 + lc * 8) * 2) = rb_[i]; } }
#define CMP(st_) { const char* la_ = lds + (st_) * 18432; const char* lb_ = lds + 36864 + (st_) * 18432; bf16x8 af[2][4], bfv[2][4]; \
      _Pragma("unroll") for (int kc = 0; kc < 2; kc++) { \
      _Pragma("unroll") for (int m = 0; m < 4; m++) af[kc][m] = *(const bf16x8*)(la_ + ((wr * 64 + m * 16 + fr) * 72 + kc * 32 + fq * 8) * 2); \
      _Pragma("unroll") for (int n = 0; n < 4; n++) bfv[kc][n] = *(const bf16x8*)(lb_ + ((wc * 64 + n * 16 + fr) * 72 + kc * 32 + fq * 8) * 2); } \
      __builtin_amdgcn_sched_barrier(0); \
      _Pragma("unroll") for (int kc = 0; kc < 2; kc++) \
      _Pragma("unroll") for (int m = 0; m < 4; m++) _Pragma("unroll") for (int n = 0; n < 4; n++) acc[m][n] = __builtin_amdgcn_mfma_f32_16x16x32_bf16(bfv[kc][n], af[kc][m], acc[m][n], 0, 0, 0); \
      __builtin_amdgcn_sched_barrier(0); }
#define RBAR { asm volatile("s_waitcnt lgkmcnt(0)" ::: "memory"); __builtin_amdgcn_s_barrier(); asm volatile("" ::: "memory"); }
  GL(ra0, rb0, 0)
  LS(ra0, rb0, 0) RBAR
  for (int kt = 0; kt < nk; kt += 2) {
    GL(ra0, rb0, kt + 1)
    CMP(0)
    LS(ra0, rb0, 1)
    RBAR
    if (kt + 2 < nk) GL(ra0, rb0, kt + 2)
    CMP(1)
    if (kt + 2 < nk) LS(ra0, rb0, 0)
    RBAR
  }
#undef GL
#undef LS
#undef CMP
#undef RBAR
  if (ROWSS) {
    float* rs = (float*)(lds + 73728);
#pragma unroll
    for (int i = 0; i < 4; i++) {
      float v = ss[i]; v += __shfl_xor(v, 1); v += __shfl_xor(v, 2); v += __shfl_xor(v, 4);
      if (lc == 0) rs[lr + 32 * i] = rsqrtf(v / (float)K + eps);
    }
    __syncthreads();
  }
}
__device__ __forceinline__ void gemm_mainloop_d(const bf16_t* __restrict__ Ap, int lda, const bf16_t* __restrict__ Bt, int K,
                                                int m0, int n0, f32x4 (&acc)[4][4], char* lds) {
  const int tid = opaque_tid(), lane = tid & 63, wid = tid >> 6, wr = wid >> 1, wc = wid & 1, fr = lane & 15, fq = lane >> 4;
#pragma unroll
  for (int m = 0; m < 4; m++)
#pragma unroll
    for (int n = 0; n < 4; n++) acc[m][n] = (f32x4){0.f, 0.f, 0.f, 0.f};
  const int nk = K >> 6;
  const int lrow = tid >> 3, cph = tid & 7;
  auto dma = [&](int kt, int st) {
    char* la = lds + st * 32768; char* lb = la + 16384;
#pragma unroll
    for (int i = 0; i < 4; i++) {
      const int row = i * 32 + lrow; const int c = cph ^ ((row >> 1) & 7);
      __builtin_amdgcn_global_load_lds((const unsigned*)(Ap + (size_t)(m0 + row) * lda + kt * 64 + c * 8), (__attribute__((address_space(3))) unsigned*)(la + i * 4096 + tid * 16), 16, 0, 0);
      __builtin_amdgcn_global_load_lds((const unsigned*)(Bt + (size_t)(n0 + row) * K + kt * 64 + c * 8), (__attribute__((address_space(3))) unsigned*)(lb + i * 4096 + tid * 16), 16, 0, 0);
    }
  };
  dma(0, 0);
  asm volatile("s_waitcnt vmcnt(0)" ::: "memory"); __builtin_amdgcn_s_barrier(); asm volatile("" ::: "memory");
  for (int kt = 0; kt < nk; kt++) {
    const int st = kt & 1;
    if (kt + 1 < nk) dma(kt + 1, st ^ 1);
    const char* la = lds + st * 32768; const char* lb = la + 16384;
    bf16x8 af[2][4], bfv[2][4];
#pragma unroll
    for (int kc = 0; kc < 2; kc++) {
#pragma unroll
      for (int m = 0; m < 4; m++) { const int row = wr * 64 + m * 16 + fr; af[kc][m] = *(const bf16x8*)(la + (row * 8 + ((kc * 4 + fq) ^ ((row >> 1) & 7))) * 16); }
#pragma unroll
      for (int n = 0; n < 4; n++) { const int row = wc * 64 + n * 16 + fr; bfv[kc][n] = *(const bf16x8*)(lb + (row * 8 + ((kc * 4 + fq) ^ ((row >> 1) & 7))) * 16); }
    }
    __builtin_amdgcn_s_setprio(1);
#pragma unroll
    for (int kc = 0; kc < 2; kc++)
#pragma unroll
      for (int m = 0; m < 4; m++)
#pragma unroll
        for (int n = 0; n < 4; n++) acc[m][n] = __builtin_amdgcn_mfma_f32_16x16x32_bf16(bfv[kc][n], af[kc][m], acc[m][n], 0, 0, 0);
    __builtin_amdgcn_s_setprio(0);
    asm volatile("s_waitcnt vmcnt(0) lgkmcnt(0)" ::: "memory"); __builtin_amdgcn_s_barrier(); asm volatile("" ::: "memory");
  }
}
__device__ __forceinline__ void gemm_GU_probe(const Params& p, int item, char* lds) {
  const int mt = item / 44, nt = item % 44; const int m0 = mt * 128, n0 = nt * 128;
  f32x4 acc[4][4];
  gemm_mainloop_d((const bf16_t*)(WS(p) + OFF_XB), DM, (const bf16_t*)(WS(p) + OFF_WGU), DM, m0, n0, acc, lds);
  float s = 0.f;
#pragma unroll
  for (int m = 0; m < 4; m++)
#pragma unroll
    for (int n = 0; n < 4; n++) s += acc[m][n][0] + acc[m][n][1] + acc[m][n][2] + acc[m][n][3];
  if (s == 12345.678f) ((float*)(WS(p) + OFF_Z))[opaque_tid()] = s;
}
#define GEMM_IDS const int tid = opaque_tid(), lane = tid & 63, wid = tid >> 6, wr = wid >> 1, wc = wid & 1, fr = lane & 15, fq = lane >> 4; (void)tid;

__device__ __forceinline__ void gemm_A(const Params& p, int item, char* lds) {
  const int mt = item / 18, nt = item % 18; const int m0 = mt * 128, n0 = nt * 128;
  f32x4 acc[4][4];
  gemm_mainloop_d((const bf16_t*)(WS(p) + OFF_XB), DM, (const bf16_t*)(WS(p) + OFF_WIN), DM, m0, n0, acc, lds);
  GEMM_IDS
  const float* rssg = (const float*)(WS(p) + OFF_RSS) + m0;
  bf16_t* P = (bf16_t*)(WS(p) + OFF_P);
#pragma unroll
  for (int m = 0; m < 4; m++) {
    const int rl = wr * 64 + m * 16 + fr; const float r = rsqrtf(rssg[rl] * (1.f / 1024.f) + 1e-6f);
    float sq = 0.f;
#pragma unroll
    for (int n = 0; n < 4; n++) {
      const int col = n0 + wc * 64 + n * 16 + fq * 4;
      if (col < PIN) { f32x4 v = acc[m][n] * r; u32x2 w; w[0] = pk2(v[0], v[1]); w[1] = pk2(v[2], v[3]); *(u32x2*)(P + (size_t)(m0 + rl) * PIN + col) = w;
        const float b0 = bflo(w[0]), b1 = bfhi(w[0]), b2 = bflo(w[1]), b3 = bfhi(w[1]); sq += b0 * b0 + b1 * b1 + b2 * b2 + b3 * b3; }
    }
    if (nt < 4) {
      sq += __shfl_xor(sq, 16); sq += __shfl_xor(sq, 32);
      if (fq == 0) unsafeAtomicAdd((float*)(WS(p) + OFF_RSS) + (2 + (nt >> 1)) * T + m0 + rl, sq);
    }
  }
}
__device__ __forceinline__ void gemm_Q(const Params& p, int item, char* lds) {
  const int mt = item / 6, nt = item % 6; const int m0 = mt * 128, n0 = nt * 128;
  f32x4 acc[4][4];
  gemm_mainloop_d((const bf16_t*)(WS(p) + OFF_P) + C_CQ, PIN, (const bf16_t*)(WS(p) + OFF_WUQ), 256, m0, n0, acc, lds);
  GEMM_IDS
  const float* rsq = (const float*)(WS(p) + OFF_RSS) + 2 * T + m0;
  bf16_t* Q = (bf16_t*)(WS(p) + OFF_Q);
  const float qs = 0.07216878364870322f * 1.4426950408889634f;
  const int cw = n0 + wc * 64; const int h = cw / 192; const int dw = cw - h * 192;
  const bool ispe = (dw == 128);
#pragma unroll
  for (int m = 0; m < 4; m++) {
    const int rl = wr * 64 + m * 16 + fr; const int tok = m0 + rl; const float r = rsqrtf(rsq[rl] * (1.f / 256.f) + 1e-6f) * qs;
    const int b = tok >> 12, s = tok & 4095;
    f32x4 v[4];
#pragma unroll
    for (int n = 0; n < 4; n++) v[n] = acc[m][n] * r;
    if (ispe) {
      const int ps = p.pos[tok];
#pragma unroll
      for (int n = 0; n < 2; n++)
#pragma unroll
        for (int j = 0; j < 4; j++) {
          float c, sn; rope_cs(ps, n * 16 + fq * 4 + j, c, sn);
          const float x1 = v[n][j], x2 = v[n + 2][j];
          v[n][j] = x1 * c - x2 * sn; v[n + 2][j] = x1 * sn + x2 * c;
        }
    }
    bf16_t* dst = Q + ((size_t)((b * 4 + h) * S + s)) * 192 + dw;
#pragma unroll
    for (int n = 0; n < 4; n++) { u32x2 w; w[0] = pk2(v[n][0], v[n][1]); w[1] = pk2(v[n][2], v[n][3]); *(u32x2*)(dst + n * 16 + fq * 4) = w; }
    __builtin_amdgcn_sched_barrier(0);
  }
  __syncthreads();
}
__device__ __forceinline__ void gemm_KV(const Params& p, int item, char* lds) {
  const int mt = item / 8, nt = item % 8; const int m0 = mt * 128, n0 = nt * 128;
  f32x4 acc[4][4];
  gemm_mainloop_d((const bf16_t*)(WS(p) + OFF_P) + C_CKV, PIN, (const bf16_t*)(WS(p) + OFF_WUKV), 256, m0, n0, acc, lds);
  GEMM_IDS
  const float* rsq = (const float*)(WS(p) + OFF_RSS) + 3 * T + m0;
  bf16_t* KN = (bf16_t*)(WS(p) + OFF_KN); bf16_t* VT = (bf16_t*)(WS(p) + OFF_VT);
  const int h = n0 >> 8; const bool isV = (n0 & 128) != 0;
  const int b = m0 >> 12, s0 = m0 & 4095;
  if (!isV) {
#pragma unroll
    for (int m = 0; m < 4; m++) {
      const int rl = wr * 64 + m * 16 + fr; const float r = rsqrtf(rsq[rl] * (1.f / 256.f) + 1e-6f);
#pragma unroll
      for (int n = 0; n < 4; n++) {
        f32x4 v = acc[m][n] * r; const int d = wc * 64 + n * 16 + fq * 4;
        u32x2 w; w[0] = pk2(v[0], v[1]); w[1] = pk2(v[2], v[3]);
        *(u32x2*)(KN + ((size_t)((b * 4 + h) * S + s0 + rl)) * 128 + d) = w;
      }
    }
  } else {
    bf16_t* tl = (bf16_t*)lds;
#pragma unroll
    for (int m = 0; m < 4; m++) {
      const int rl = wr * 64 + m * 16 + fr; const float r = rsqrtf(rsq[rl] * (1.f / 256.f) + 1e-6f);
      const int k32 = rl & 31; const int rlp = (rl & ~31) | ((k32 < 16) ? ((k32 >> 2) * 8 + (k32 & 3)) : (((k32 - 16) >> 2) * 8 + 4 + (k32 & 3)));
#pragma unroll
      for (int n = 0; n < 4; n++) {
        f32x4 v = acc[m][n] * r; const int d = wc * 64 + n * 16 + fq * 4;
#pragma unroll
        for (int j = 0; j < 4; j++) tl[(d + j) * 132 + rlp] = f2bf(v[j]);
      }
    }
    __syncthreads();
    const int dv = tid >> 4, c16 = tid & 15;
#pragma unroll
    for (int i = 0; i < 8; i++) {
      const int row = dv + 16 * i;
      const u32x2 lo = *(const u32x2*)(tl + row * 132 + c16 * 8), hi = *(const u32x2*)(tl + row * 132 + c16 * 8 + 4);
      u32x4 w; w[0] = lo[0]; w[1] = lo[1]; w[2] = hi[0]; w[3] = hi[1];
      *(u32x4*)(VT + ((size_t)((b * 4 + h) * 128 + row)) * S + s0 + c16 * 8) = w;
    }
  }
  __syncthreads();
}
__device__ __forceinline__ void gemm_RES(const bf16_t* A, int K, const bf16_t* Bt, const float* xin, float* xout, bf16_t* xb, float* rss, int item, char* lds) {
  const int mt = item >> 3, nt = item & 7; const int m0 = mt * 128, n0 = nt * 128;
  f32x4 acc[4][4];
  gemm_mainloop_d(A, K, Bt, K, m0, n0, acc, lds);
  GEMM_IDS
#pragma unroll
  for (int m = 0; m < 4; m++) {
    const int rowg = m0 + wr * 64 + m * 16 + fr;
    const size_t ro = (size_t)rowg * DM;
    float sq = 0.f;
#pragma unroll
    for (int n = 0; n < 4; n++) {
      const int col = n0 + wc * 64 + n * 16 + fq * 4;
      f32x4 xv = *(const f32x4*)(xin + ro + col);
      const f32x4 xn = xv + acc[m][n];
      *(f32x4*)(xout + ro + col) = xn;
      u32x2 w; w[0] = pk2(xn[0], xn[1]); w[1] = pk2(xn[2], xn[3]); *(u32x2*)(xb + ro + col) = w;
      const float b0 = bflo(w[0]), b1 = bfhi(w[0]), b2 = bflo(w[1]), b3 = bfhi(w[1]);
      sq += b0 * b0 + b1 * b1 + b2 * b2 + b3 * b3;
    }
    sq += __shfl_xor(sq, 16); sq += __shfl_xor(sq, 32);
    if (fq == 0) unsafeAtomicAdd(rss + rowg, sq);
  }
}
__device__ __forceinline__ void gemm_GU(const Params& p, int item, char* lds) {
  const int r_ = item >> 9, x_ = item & 7, y_ = (item >> 3) & 63;
  const int pid = (r_ * 8 + x_) * 2 + (y_ >> 5), t32 = y_ & 31;
  const int mt = (pid / 11) * 8 + (t32 >> 2), nt = (pid % 11) * 4 + (t32 & 3); const int m0 = mt * 128, n0 = nt * 128;
  f32x4 acc[4][4];
  gemm_mainloop_d((const bf16_t*)(WS(p) + OFF_XB), DM, (const bf16_t*)(WS(p) + OFF_WGU), DM, m0, n0, acc, lds);
  GEMM_IDS
  const float* rssg = (const float*)(WS(p) + OFF_RSS) + T + m0;
  bf16_t* U = (bf16_t*)(WS(p) + OFF_U);
#pragma unroll
  for (int m = 0; m < 4; m++) {
    const int rl = wr * 64 + m * 16 + fr; const float r = rsqrtf(rssg[rl] * (1.f / 1024.f) + 1e-6f);
#pragma unroll
    for (int i = 0; i < 2; i++) {
      f32x4 g = acc[m][2 * i] * r, u = acc[m][2 * i + 1] * r, o;
#pragma unroll
      for (int j = 0; j < 4; j++) o[j] = g[j] * sigmoidf_(g[j]) * u[j];
      const int col = (n0 >> 1) + wc * 32 + i * 16 + fq * 4;
      u32x2 w; w[0] = pk2(o[0], o[1]); w[1] = pk2(o[2], o[3]);
      *(u32x2*)(U + (size_t)(m0 + rl) * DFF + col) = w;
    }
  }
  __syncthreads();
}

__device__ __forceinline__ void rwkv_prep_item(const Params& p, int l, int item, char* ldsraw) {
  float* lds = (float*)ldsraw;
  const bf16_t* P = (const bf16_t*)(WS(p) + OFF_P);
  float* RW = (float*)(WS(p) + OFF_RW); bf16_t* RB = (bf16_t*)(WS(p) + OFF_RB); float* RC = (float*)(WS(p) + OFF_RC);
  const int tid = opaque_tid(), h = tid >> 6, jl = tid & 63;
  const int tok0 = item * 16, b = tok0 >> 12, s0 = tok0 & 4095;
  const float* mu = p.mu + l * 896;
#pragma unroll
  for (int i = 0; i < 4; i++) {
    int idx = tid + 256 * i; int t = idx >> 6, c = idx & 63;
    int col = C_RW + 768 + c; int tok = tok0 + t;
    float cur = bf2f(P[(size_t)tok * PIN + col]);
    float prv = (s0 + t > 0) ? bf2f(P[(size_t)(tok - 1) * PIN + col]) : 0.f;
    float v = cur + (prv - cur) * mu[768 + c];
    if (c < 32) { float e = __expf(2.f * v); v = 1.f - 2.f / (1.f + e); }
    lds[t * 64 + c] = v;
  }
  __syncthreads();
  {
    float wl[16], al[16];
    const float w0j = p.w0[l * 256 + tid], a0j = p.a0[l * 256 + tid];
#pragma unroll
    for (int t = 0; t < 16; t++) { wl[t] = w0j; al[t] = a0j; }
    const float* w2 = p.w2 + (size_t)l * 32 * 256 + tid; const float* a2 = p.a2 + (size_t)l * 32 * 256 + tid;
    float w2c[32], a2c[32];
#pragma unroll
    for (int i = 0; i < 32; i++) { w2c[i] = w2[i * 256]; a2c[i] = a2[i * 256]; }
#pragma unroll
    for (int i4 = 0; i4 < 8; i4++) {
#pragma unroll
      for (int t = 0; t < 16; t++) {
        const f32x4 xw = *(const f32x4*)(lds + t * 64 + i4 * 4), xa = *(const f32x4*)(lds + t * 64 + 32 + i4 * 4);
        wl[t] += xw[0] * w2c[i4 * 4] + xw[1] * w2c[i4 * 4 + 1] + xw[2] * w2c[i4 * 4 + 2] + xw[3] * w2c[i4 * 4 + 3];
        al[t] += xa[0] * a2c[i4 * 4] + xa[1] * a2c[i4 * 4 + 1] + xa[2] * a2c[i4 * 4 + 2] + xa[3] * a2c[i4 * 4 + 3];
      }
    }
#pragma unroll
    for (int t = 0; t < 16; t++) { lds[1024 + t * 256 + tid] = wl[t]; lds[1024 + 4096 + t * 256 + tid] = al[t]; }
  }
  const float kkj = p.k_k[l * 256 + tid], kaj = p.k_a[l * 256 + tid], rkj = p.r_k[l * 256 + tid];
  const float mur = mu[tid], muk = mu[256 + tid], muv = mu[512 + tid];
  bf16_t* stg = (bf16_t*)(lds + 9216);
  {
    u32x4 sv[7];
#pragma unroll
    for (int k = 0; k < 7; k++) {
      const int c = tid + 256 * k; const int cc2 = (c < 17 * 96) ? c : 0; const int rw = cc2 / 96, cc = cc2 - rw * 96;
      const int rr = (rw > 0 || s0 > 0) ? rw : 1;
      sv[k] = *(const u32x4*)(P + (size_t)(tok0 + rr - 1) * PIN + C_RW + cc * 8);
    }
#pragma unroll
    for (int k = 0; k < 7; k++) {
      const int c = tid + 256 * k; const int rw = c / 96, cc = c - rw * 96;
      u32x4 w = sv[k]; if (rw == 0 && s0 == 0) w = (u32x4){0u, 0u, 0u, 0u};
      if (c < 17 * 96) *(u32x4*)(stg + rw * 768 + cc * 8) = w;
    }
  }
  __syncthreads();
#pragma unroll 2
  for (int t = 0; t < 16; t++) {
    const int s = s0 + t;
    const bf16_t* pc = stg + (t + 1) * 768; const bf16_t* pp = stg + t * 768;
    float r = bf2f(pc[tid]), k = bf2f(pc[256 + tid]), v = bf2f(pc[512 + tid]);
    const float rp = bf2f(pp[tid]), kp = bf2f(pp[256 + tid]), vp = bf2f(pp[512 + tid]);
    r += (rp - r) * mur; k += (kp - k) * muk; v += (vp - v) * muv;
    const float wl = lds[1024 + t * 256 + tid], al = lds[1024 + 4096 + t * 256 + tid];
    const float decay = __expf(-0.6065306597126334f * sigmoidf_(wl));
    const float a = sigmoidf_(al);
    const float kkr = k * kkj;
    const float ssq = wave_sum(kkr * kkr);
    const float kk = kkr * rsqrtf(fmaxf(ssq, 1e-24f));
    const float km = k * (1.f + (a - 1.f) * kaj);
    const float kka = kk * a, wr = decay * r;
    const float c1 = wave_sum(kka * r), c2 = wave_sum(km * r), c3 = wave_sum(r * km * rkj);
    const size_t base = (size_t)(b * 4 + h) * S + s;
    RW[base * 64 + jl] = decay;
    bf16_t* rb = RB + base * 320;
    rb[jl] = f2bf(kk); rb[64 + jl] = f2bf(kka); rb[128 + jl] = f2bf(km); rb[192 + jl] = f2bf(wr); rb[256 + jl] = f2bf(v);
    if (jl == 0) { f32x4 c; c[0] = c1; c[1] = c2; c[2] = c3; c[3] = 0.f; *(f32x4*)(RC + base * 4) = c; }
  }
  bf16_t* KPE = (bf16_t*)(WS(p) + OFF_KPE);
#pragma unroll
  for (int i = 0; i < 2; i++) {
    int idx = tid + 256 * i; int t = idx >> 5, f = idx & 31; int tok = tok0 + t;
    float x1 = bf2f(P[(size_t)tok * PIN + C_KPE + f]), x2 = bf2f(P[(size_t)tok * PIN + C_KPE + 32 + f]);
    float c, sn; rope_cs(p.pos[tok], f, c, sn);
    KPE[(size_t)tok * 64 + f] = f2bf(x1 * c - x2 * sn); KPE[(size_t)tok * 64 + 32 + f] = f2bf(x1 * sn + x2 * c);
  }
  __syncthreads();
}

template <int VAR>
__device__ __forceinline__ void rwkv_scan_item(const Params& p, int item, char* ldsraw) {
  const float* RW = (const float*)(WS(p) + OFF_RW); const bf16_t* RB = (const bf16_t*)(WS(p) + OFF_RB); const float* RC = (const float*)(WS(p) + OFF_RC);
  bf16_t* YR = (bf16_t*)(WS(p) + (VAR ? OFF_Q : OFF_Y));
  float* buf = (float*)ldsraw;
  constexpr int STEP = 340;
  const int bh = item >> 2, rq = item & 3, b = bh >> 2, h = bh & 3;
  const int tid = opaque_tid(), lane = tid & 63, wid = tid >> 6, jl = lane & 15, rl = lane >> 4;
  const int row = rq * 16 + wid * 4 + rl;
  const int st = tid >> 4, part = tid & 15;
  f32x4 pw; u32x2 pkk, pkka, pk, pwr; unsigned short pv; float pc;
  auto load = [&](int chunk) {
    const size_t base = (size_t)bh * S + chunk * 16 + st;
    pw = *(const f32x4*)(RW + base * 64 + part * 4);
    const bf16_t* rb = RB + base * 320;
    pkk = *(const u32x2*)(rb + part * 4); pkka = *(const u32x2*)(rb + 64 + part * 4);
    pk = *(const u32x2*)(rb + 128 + part * 4); pwr = *(const u32x2*)(rb + 192 + part * 4);
    pv = rb[256 + rq * 16 + part];
    pc = (part < 2) ? RC[base * 4 + part] : 0.f;
  };
  auto store = [&](int bi) {
    float* d = buf + bi * 16 * STEP + st * STEP;
    *(f32x4*)(d + part * 4) = pw;
    *(f32x4*)(d + 64 + part * 4) = (f32x4){bflo(pkk[0]), bfhi(pkk[0]), bflo(pkk[1]), bfhi(pkk[1])};
    *(f32x4*)(d + 128 + part * 4) = (f32x4){bflo(pkka[0]), bfhi(pkka[0]), bflo(pkka[1]), bfhi(pkka[1])};
    *(f32x4*)(d + 192 + part * 4) = (f32x4){bflo(pk[0]), bfhi(pk[0]), bflo(pk[1]), bfhi(pk[1])};
    *(f32x4*)(d + 256 + part * 4) = (f32x4){bflo(pwr[0]), bfhi(pwr[0]), bflo(pwr[1]), bfhi(pwr[1])};
    d[320 + part] = bf2f(pv);
    if (part < 2) d[336 + part] = pc;
  };
  __builtin_amdgcn_s_setprio(3);
  load(0); store(0); __syncthreads();
  float s0 = 0.f, s1 = 0.f, s2 = 0.f, s3 = 0.f;
  bf16_t* yout = YR + ((size_t)b * S + jl) * 1024 + 512 + h * 64 + row;
#define SCAN_LOAD(q) { const float* ds_ = d + (q) * STEP; nw = *(const f32x4*)(ds_); nkk = *(const f32x4*)(ds_ + 64); nkka = *(const f32x4*)(ds_ + 128); \
    nk = *(const f32x4*)(ds_ + 192); nwr = *(const f32x4*)(ds_ + 256); nv = dvp[(q) * STEP]; ncc = *(const f32x2*)(dcp + (q) * STEP); }
#pragma unroll 1
  for (int c = 0; c < 256; c++) {
    if (c + 1 < 256) load(c + 1);
    const float* d = buf + (c & 1) * 16 * STEP + jl * 4;
    const float* dvp = buf + (c & 1) * 16 * STEP + 320 + wid * 4 + rl;
    const float* dcp = buf + (c & 1) * 16 * STEP + 336;
    f32x4 nw, nkk, nkka, nk, nwr; float nv; f32x2 ncc;
    SCAN_LOAD(0)
    float ykeep = 0.f;
#pragma unroll
    for (int q = 0; q < (VAR == 4 ? 0 : 16); q++) {
      const f32x4 cw = nw, ckk = nkk, ckka = nkka, ck = nk, cwr = nwr; const float cv = nv; const f32x2 ccc = ncc;
      if (q < 15 && VAR != 3) SCAN_LOAD(q + 1)
      __builtin_amdgcn_sched_barrier(0);
      float m0 = mul_s(s0, ckk.x), m1 = mul_s(s2, ckk.z), n0 = mul_s(s0, cwr.x), n1 = mul_s(s2, cwr.z);
      m0 = fma_s(s1, ckk.y, m0); m1 = fma_s(s3, ckk.w, m1); n0 = fma_s(s1, cwr.y, n0); n1 = fma_s(s3, cwr.w, n1);
      float psa = add_s(m0, m1), pu = add_s(n0, n1);
      if (VAR != 2) { psa = row16_sum(psa); pu = row16_sum(pu); }
      const float t0 = fnma_s(psa, ckka.x, mul_s(cv, ck.x)), t1 = fnma_s(psa, ckka.y, mul_s(cv, ck.y));
      const float t2 = fnma_s(psa, ckka.z, mul_s(cv, ck.z)), t3 = fnma_s(psa, ckka.w, mul_s(cv, ck.w));
      s0 = fma_s(s0, cw.x, t0); s1 = fma_s(s1, cw.y, t1); s2 = fma_s(s2, cw.z, t2); s3 = fma_s(s3, cw.w, t3);
      const float y = fnma_s(psa, ccc.x, fma_s(cv, ccc.y, pu));
      ykeep = sel_eq(ykeep, y, jl, q);
    }
    if (c + 1 < 256) store((c + 1) & 1);
    __builtin_amdgcn_sched_barrier(0);
    yout[(size_t)c * 16 * 1024] = f2bf(ykeep);
    __syncthreads();
  }
#undef SCAN_LOAD
  __builtin_amdgcn_s_setprio(0);
}

__device__ __forceinline__ void rwkv_scan2_item(const Params& p, int item, char* ldsraw) {
  const float* RW = (const float*)(WS(p) + OFF_RW); const bf16_t* RB = (const bf16_t*)(WS(p) + OFF_RB); const float* RC = (const float*)(WS(p) + OFF_RC);
  bf16_t* Yb = (bf16_t*)(WS(p) + OFF_Y);
  float* buf = (float*)ldsraw;
  constexpr int STEP = 340, CH = 16 * STEP;
  float* SA = buf + 3 * CH;
  const int bh = item / 12, rr = item - bh * 12, b = bh >> 2, h = bh & 3;
  const int seg = (rr >= 4) ? 1 : 0, ident = (rr >= 8) ? 1 : 0, r16 = rr & 3;
  const int c0 = seg * 128;
  const int tid = opaque_tid(), lane = tid & 63, wid = tid >> 6, jl = lane & 15, rl = lane >> 4;
  const int isY = wid >> 1, row8 = (wid & 1) * 4 + rl;
  const int rowA = r16 * 16 + row8;
  const int st = tid >> 4, part = tid & 15;
  f32x4 pw; u32x2 pkk, pkka, pk, pwr; unsigned short pv; float pc;
  auto load = [&](int chunk) {
    const size_t base = (size_t)bh * S + chunk * 16 + st;
    pw = *(const f32x4*)(RW + base * 64 + part * 4);
    const bf16_t* rb = RB + base * 320;
    pkk = *(const u32x2*)(rb + part * 4); pkka = *(const u32x2*)(rb + 64 + part * 4);
    pk = *(const u32x2*)(rb + 128 + part * 4); pwr = *(const u32x2*)(rb + 192 + part * 4);
    pv = rb[256 + r16 * 16 + part];
    pc = (part < 2) ? RC[base * 4 + part] : 0.f;
  };
  auto store = [&](int bi) {
    float* d = buf + bi * CH + st * STEP;
    *(f32x4*)(d + part * 4) = pw;
    *(f32x4*)(d + 64 + part * 4) = (f32x4){bflo(pkk[0]), bfhi(pkk[0]), bflo(pkk[1]), bfhi(pkk[1])};
    *(f32x4*)(d + 128 + part * 4) = (f32x4){bflo(pkka[0]), bfhi(pkka[0]), bflo(pkka[1]), bfhi(pkka[1])};
    *(f32x4*)(d + 192 + part * 4) = (f32x4){bflo(pk[0]), bfhi(pk[0]), bflo(pk[1]), bfhi(pk[1])};
    *(f32x4*)(d + 256 + part * 4) = (f32x4){bflo(pwr[0]), bfhi(pwr[0]), bflo(pwr[1]), bfhi(pwr[1])};
    d[320 + part] = ident ? 0.f : bf2f(pv);
    if (part < 2) d[336 + part] = pc;
  };
  load(c0); store(0); __syncthreads();
  float a0 = 0.f, a1 = 0.f, a2 = 0.f, a3 = 0.f, b0 = 0.f, b1 = 0.f, b2 = 0.f, b3 = 0.f;
  if (ident) {
    const int mA = rowA - jl * 4, mB = mA + 8;
    a0 = (mA == 0) ? 1.f : 0.f; a1 = (mA == 1) ? 1.f : 0.f; a2 = (mA == 2) ? 1.f : 0.f; a3 = (mA == 3) ? 1.f : 0.f;
    b0 = (mB == 0) ? 1.f : 0.f; b1 = (mB == 1) ? 1.f : 0.f; b2 = (mB == 2) ? 1.f : 0.f; b3 = (mB == 3) ? 1.f : 0.f;
  }
  bf16_t* yout = ident ? (bf16_t*)(WS(p) + OFF_Z) + ((size_t)bh * 2048 + jl) * 64 + rowA
                       : Yb + ((size_t)b * S + c0 * 16 + jl) * 1024 + 512 + h * 64 + rowA;
  const size_t ystride = ident ? (size_t)16 * 64 : (size_t)16 * 1024;
  int bi = 0;
#pragma unroll 1
  for (int c = 0; c <= 128; c++) {
    if (c + 1 < 128) load(c0 + c + 1);
    const int bprev = (bi == 0) ? 2 : bi - 1, bnext = (bi == 2) ? 0 : bi + 1;
    if (!isY) {
      if (c < 128) {
        const float* d = buf + bi * CH + jl * 4;
        const float* dvp = buf + bi * CH + 320 + row8;
        f32x4 nw, nkk, nkka, nk; float nvA, nvB;
#define R_LOAD(q) { const float* ds_ = d + (q) * STEP; nw = *(const f32x4*)(ds_); nkk = *(const f32x4*)(ds_ + 64); nkka = *(const f32x4*)(ds_ + 128); nk = *(const f32x4*)(ds_ + 192); nvA = dvp[(q) * STEP]; nvB = dvp[(q) * STEP + 8]; }
        R_LOAD(0)
        float sakA = 0.f, sakB = 0.f;
#pragma unroll
        for (int q = 0; q < 16; q++) {
          const f32x4 cw = nw, ckk = nkk, ckka = nkka, ck = nk; const float cvA = nvA, cvB = nvB;
          if (q < 15) R_LOAD(q + 1)
          __builtin_amdgcn_sched_barrier(0);
          float mA0 = mul_s(a0, ckk.x), mA1 = mul_s(a2, ckk.z), mB0 = mul_s(b0, ckk.x), mB1 = mul_s(b2, ckk.z);
          mA0 = fma_s(a1, ckk.y, mA0); mA1 = fma_s(a3, ckk.w, mA1); mB0 = fma_s(b1, ckk.y, mB0); mB1 = fma_s(b3, ckk.w, mB1);
          float psA = add_s(mA0, mA1), psB = add_s(mB0, mB1);
          psA = row16_sum(psA); psB = row16_sum(psB);
          { const float t0 = fnma_s(psA, ckka.x, mul_s(cvA, ck.x)), t1 = fnma_s(psA, ckka.y, mul_s(cvA, ck.y));
            const float t2 = fnma_s(psA, ckka.z, mul_s(cvA, ck.z)), t3 = fnma_s(psA, ckka.w, mul_s(cvA, ck.w));
            a0 = fma_s(a0, cw.x, t0); a1 = fma_s(a1, cw.y, t1); a2 = fma_s(a2, cw.z, t2); a3 = fma_s(a3, cw.w, t3); }
          { const float t0 = fnma_s(psB, ckka.x, mul_s(cvB, ck.x)), t1 = fnma_s(psB, ckka.y, mul_s(cvB, ck.y));
            const float t2 = fnma_s(psB, ckka.z, mul_s(cvB, ck.z)), t3 = fnma_s(psB, ckka.w, mul_s(cvB, ck.w));
            b0 = fma_s(b0, cw.x, t0); b1 = fma_s(b1, cw.y, t1); b2 = fma_s(b2, cw.z, t2); b3 = fma_s(b3, cw.w, t3); }
          sakA = sel_eq(sakA, psA, jl, q); sakB = sel_eq(sakB, psB, jl, q);
        }
#undef R_LOAD
        SA[(c & 1) * 256 + jl * 16 + row8] = sakA; SA[(c & 1) * 256 + jl * 16 + 8 + row8] = sakB;
      }
    } else {
      if (c >= 1) {
        const float* d = buf + bprev * CH + jl * 4;
        const float* dvp = buf + bprev * CH + 320 + row8;
        const float* dcp = buf + bprev * CH + 336;
        const float* sap = SA + ((c - 1) & 1) * 256 + row8;
        f32x4 nw, nkka, nk, nwr; float nvA, nvB, nsA, nsB; f32x2 ncc;
#define Y_LOAD(q) { const float* ds_ = d + (q) * STEP; nw = *(const f32x4*)(ds_); nkka = *(const f32x4*)(ds_ + 128); nk = *(const f32x4*)(ds_ + 192); nwr = *(const f32x4*)(ds_ + 256); \
          nvA = dvp[(q) * STEP]; nvB = dvp[(q) * STEP + 8]; ncc = *(const f32x2*)(dcp + (q) * STEP); nsA = sap[(q) * 16]; nsB = sap[(q) * 16 + 8]; }
        Y_LOAD(0)
        float ykA = 0.f, ykB = 0.f;
#pragma unroll
        for (int q = 0; q < 16; q++) {
          const f32x4 cw = nw, ckka = nkka, ck = nk, cwr = nwr; const float cvA = nvA, cvB = nvB, psA = nsA, psB = nsB; const f32x2 ccc = ncc;
          if (q < 15) Y_LOAD(q + 1)
          __builtin_amdgcn_sched_barrier(0);
          float nA0 = mul_s(a0, cwr.x), nA1 = mul_s(a2, cwr.z), nB0 = mul_s(b0, cwr.x), nB1 = mul_s(b2, cwr.z);
          nA0 = fma_s(a1, cwr.y, nA0); nA1 = fma_s(a3, cwr.w, nA1); nB0 = fma_s(b1, cwr.y, nB0); nB1 = fma_s(b3, cwr.w, nB1);
          float puA = add_s(nA0, nA1), puB = add_s(nB0, nB1);
          puA = row16_sum(puA); puB = row16_sum(puB);
          { const float t0 = fnma_s(psA, ckka.x, mul_s(cvA, ck.x)), t1 = fnma_s(psA, ckka.y, mul_s(cvA, ck.y));
            const float t2 = fnma_s(psA, ckka.z, mul_s(cvA, ck.z)), t3 = fnma_s(psA, ckka.w, mul_s(cvA, ck.w));
            a0 = fma_s(a0, cw.x, t0); a1 = fma_s(a1, cw.y, t1); a2 = fma_s(a2, cw.z, t2); a3 = fma_s(a3, cw.w, t3); }
          { const float t0 = fnma_s(psB, ckka.x, mul_s(cvB, ck.x)), t1 = fnma_s(psB, ckka.y, mul_s(cvB, ck.y));
            const float t2 = fnma_s(psB, ckka.z, mul_s(cvB, ck.z)), t3 = fnma_s(psB, ckka.w, mul_s(cvB, ck.w));
            b0 = fma_s(b0, cw.x, t0); b1 = fma_s(b1, cw.y, t1); b2 = fma_s(b2, cw.z, t2); b3 = fma_s(b3, cw.w, t3); }
          const float yA = fnma_s(psA, ccc.x, fma_s(cvA, ccc.y, puA)), yB = fnma_s(psB, ccc.x, fma_s(cvB, ccc.y, puB));
          ykA = sel_eq(ykA, yA, jl, q); ykB = sel_eq(ykB, yB, jl, q);
        }
#undef Y_LOAD
        yout[(size_t)(c - 1) * ystride] = f2bf(ykA); yout[(size_t)(c - 1) * ystride + 8] = f2bf(ykB);
      }
    }
    if (c + 1 < 128) store(bnext);
    bi = bnext;
    asm volatile("s_waitcnt lgkmcnt(0)" ::: "memory"); __builtin_amdgcn_s_barrier(); asm volatile("" ::: "memory");
  }
  if (seg == 0 && !isY) {
    float* sf = (float*)(WS(p) + OFF_SF) + ((size_t)bh * 64 + rowA) * 64 + jl * 4;
    *(f32x4*)sf = (f32x4){a0, a1, a2, a3}; *(f32x4*)(sf + 8 * 64) = (f32x4){b0, b1, b2, b3};
  }
}

__device__ __forceinline__ void rwkv_fin_item(const Params& p, int l, int item, char* ldsraw) {
  float* lds = (float*)ldsraw;
  const bf16_t* P = (const bf16_t*)(WS(p) + OFF_P);
  const bf16_t* RB = (const bf16_t*)(WS(p) + OFF_RB); const float* RC = (const float*)(WS(p) + OFF_RC);
  bf16_t* Y = (bf16_t*)(WS(p) + OFF_Y);
  const int tid = opaque_tid(), h = tid >> 6, jl = tid & 63;
  const int tok0 = item * 16, b = tok0 >> 12, s0 = tok0 & 4095;
  const float* mu = p.mu + l * 896;
#pragma unroll
  for (int i = 0; i < 4; i++) {
    int idx = tid + 256 * i; int t = idx >> 6, c = idx & 63;
    int col = C_RW + 832 + c; int tok = tok0 + t;
    float cur = bf2f(P[(size_t)tok * PIN + col]);
    float prv = (s0 + t > 0) ? bf2f(P[(size_t)(tok - 1) * PIN + col]) : 0.f;
    float v = cur + (prv - cur) * mu[832 + c];
    lds[t * 64 + c] = sigmoidf_(v);
  }
  __syncthreads();
  {
    float gacc[16];
#pragma unroll
    for (int t = 0; t < 16; t++) gacc[t] = 0.f;
    const float* g2 = p.g2 + (size_t)l * 64 * 256 + tid;
    float g2c[64];
#pragma unroll
    for (int i = 0; i < 64; i++) g2c[i] = g2[i * 256];
#pragma unroll
    for (int i4 = 0; i4 < 16; i4++) {
#pragma unroll
      for (int t = 0; t < 16; t++) {
        const f32x4 x = *(const f32x4*)(lds + t * 64 + i4 * 4);
        gacc[t] += x[0] * g2c[i4 * 4] + x[1] * g2c[i4 * 4 + 1] + x[2] * g2c[i4 * 4 + 2] + x[3] * g2c[i4 * 4 + 3];
      }
    }
#pragma unroll
    for (int t = 0; t < 16; t++) lds[1024 + t * 256 + tid] = gacc[t];
  }
  const float lw = p.ln_w[l * 256 + tid], lb = p.ln_b[l * 256 + tid];
  float yv[16], vv[16], c3v[16];
  const size_t base0 = (size_t)(b * 4 + h) * S + s0;
#pragma unroll
  for (int t = 0; t < 16; t++) { yv[t] = bf2f(Y[(size_t)(tok0 + t) * 1024 + 512 + tid]); vv[t] = bf2f(RB[(base0 + t) * 320 + 256 + jl]); c3v[t] = RC[(base0 + t) * 4 + 2]; }
  if (s0 >= 2048) {
    float* zl = lds + 5120;
    const bf16_t* Z = (const bf16_t*)(WS(p) + OFF_Z);
#pragma unroll
    for (int t = 0; t < 16; t++) zl[t * 256 + tid] = bf2f(Z[((size_t)(b * 4 + h) * 2048 + (s0 - 2048 + t)) * 64 + jl]);
    const float* sf = (const float*)(WS(p) + OFF_SF) + ((size_t)(b * 4 + h) * 64 + jl) * 64;
    __syncthreads();
#pragma unroll 1
    for (int mq = 0; mq < 16; mq++) {
      const f32x4 sv = *(const f32x4*)(sf + mq * 4);
#pragma unroll
      for (int t = 0; t < 16; t++) {
        const f32x4 zv = *(const f32x4*)(zl + t * 256 + h * 64 + mq * 4);
        yv[t] += sv[0] * zv[0] + sv[1] * zv[1] + sv[2] * zv[2] + sv[3] * zv[3];
      }
    }
  }
#pragma unroll
  for (int t = 0; t < 16; t++) {
    const float y = yv[t];
    const float mean = wave_sum(y) * (1.f / 64.f);
    const float dlt = y - mean;
    const float var = wave_sum(dlt * dlt) * (1.f / 64.f);
    const float yn = dlt * rsqrtf(var + 64e-5f) * lw + lb;
    const float g = lds[1024 + t * 256 + tid];
    Y[(size_t)(tok0 + t) * 1024 + 512 + tid] = f2bf((yn + c3v[t] * vv[t]) * g);
  }
  __syncthreads();
}

__device__ __forceinline__ float wave_scan_add_lds(volatile float* a, int t, float v) {
  a[t] = v;
#pragma unroll
  for (int o = 1; o < 64; o <<= 1) { const float u = (t >= o) ? a[t - o] : 0.f; v += u; a[t] = v; }
  return v;
}
__device__ __forceinline__ float wave_scan_max_lds(volatile float* a, int t, float v) {
  a[t] = v;
#pragma unroll
  for (int o = 1; o < 64; o <<= 1) { const float u = (t >= o) ? a[t - o] : -3.0e38f; v = fmaxf(v, u); a[t] = v; }
  return v;
}
__device__ __forceinline__ float ml_conv(const bf16_t* P, const float* cw, const float* cb, int tok, int s, int ch) {
  float acc = cb[ch];
  float xv[4], wv[4];
#pragma unroll
  for (int j = 0; j < 4; j++) { const int ds = 3 - j; const bool ok = (s - ds >= 0); const int tk = ok ? tok - ds : tok; xv[j] = bf2f(P[(size_t)tk * PIN + C_ML + ch]); wv[j] = ok ? cw[j * 256 + ch] : 0.f; }
#pragma unroll
  for (int j = 0; j < 4; j++) acc += xv[j] * wv[j];
  return acc * sigmoidf_(acc);
}
__device__ __forceinline__ void ml_stage_qk(const bf16_t* P, const float* cw, const float* cb, bf16_t* raw, float* wl, int tokb, int c, int h, int tid) {
  for (int ci = tid; ci < 67 * 8; ci += 256) {
    const int row = ci >> 3, c8 = ci & 7;
    u32x4 w = {0u, 0u, 0u, 0u};
    if (c * 64 - 3 + row >= 0) w = *(const u32x4*)(P + (size_t)(tokb - 3 + row) * PIN + C_ML + ((c8 < 4) ? (h * 32 + c8 * 8) : (128 + h * 32 + (c8 - 4) * 8)));
    *(u32x4*)(raw + row * 64 + c8 * 8) = w;
  }
  for (int i = tid; i < 320; i += 256) {
    const int x = i & 63; const int ch = (x < 32) ? (h * 32 + x) : (128 + h * 32 + (x - 32));
    wl[i] = (i < 256) ? cw[(i >> 6) * 256 + ch] : cb[ch];
  }
}
__device__ __forceinline__ float ml_conv_lds(const bf16_t* raw, const float* wl, int t, int ch) {
  float acc = wl[256 + ch];
#pragma unroll
  for (int j = 0; j < 4; j++) acc += bf2f(raw[(t + j) * 64 + ch]) * wl[j * 64 + ch];
  return acc * sigmoidf_(acc);
}
__device__ __forceinline__ void ml_p1_item(const Params& p, int l, int item, char* ldsraw) {
  float* lds = (float*)ldsraw;
  float* Ks = lds;
  float* Vs = lds + 2112;
  float* G = lds + 2112 + 4096;
  const bf16_t* P = (const bf16_t*)(WS(p) + OFF_P);
  const int bh = item >> 6, c = item & 63, b = bh >> 2, h = bh & 3;
  const int tid = opaque_tid();
  const int tokb = b * S + c * 64;
  const float* cw = p.conv_w + l * 1024; const float* cb = p.conv_b + l * 256;
  {
    bf16_t* raw = (bf16_t*)(lds + 6400); float* wl = lds + 6400 + 2144;
    ml_stage_qk(P, cw, cb, raw, wl, tokb, c, h, tid);
#pragma unroll
    for (int i = 0; i < 2; i++) {
      const int ci = tid + 256 * i; const int row = ci >> 3, c8 = ci & 7;
      const u32x4 w = *(const u32x4*)(P + (size_t)(tokb + row) * PIN + C_ML + 256 + h * 64 + c8 * 8);
      *(f32x4*)(Vs + row * 64 + c8 * 8) = (f32x4){bflo(w[0]), bfhi(w[0]), bflo(w[1]), bfhi(w[1])};
      *(f32x4*)(Vs + row * 64 + c8 * 8 + 4) = (f32x4){bflo(w[2]), bfhi(w[2]), bflo(w[3]), bfhi(w[3])};
    }
    __syncthreads();
    const int t = tid >> 2, dq = tid & 3;
#pragma unroll
    for (int i = 0; i < 8; i++) { int d = dq * 8 + i; Ks[t * 33 + d] = ml_conv_lds(raw, wl, t, 32 + d); }
  }
  float glast = 0.f, amax = 0.f;
  if (tid < 64) {
    const int t = tid;
    const float ip = bf2f(P[(size_t)(tokb + t) * PIN + C_ML + 512 + h]) + p.i_bias[l * 4 + h];
    const float fp = bf2f(P[(size_t)(tokb + t) * PIN + C_ML + 516 + h]) + p.f_bias[l * 4 + h];
    const float lf = fminf(fp, 0.f) - log1pf(__expf(-fabsf(fp)));
    volatile float* sc = G + 64;
    const float g = wave_scan_add_lds(sc, t, lf);
    glast = sc[63];
    const float a = glast - g + ip;
    amax = wave_scan_max_lds(sc + 64, t, a);
    amax = sc[64 + 63];
    G[t] = __expf(a - amax);
  }
  __syncthreads();
  {
    const int d = tid >> 3, e0 = (tid & 7) * 8;
    float accv[8]; float nacc = 0.f;
#pragma unroll
    for (int i = 0; i < 8; i++) accv[i] = 0.f;
    for (int t = 0; t < 64; t++) {
      const float kw = G[t] * Ks[t * 33 + d];
      const f32x4 v0 = *(const f32x4*)(Vs + t * 64 + e0), v1 = *(const f32x4*)(Vs + t * 64 + e0 + 4);
      accv[0] += kw * v0[0]; accv[1] += kw * v0[1]; accv[2] += kw * v0[2]; accv[3] += kw * v0[3];
      accv[4] += kw * v1[0]; accv[5] += kw * v1[1]; accv[6] += kw * v1[2]; accv[7] += kw * v1[3];
      nacc += kw;
    }
    float* MLC = (float*)(WS(p) + OFF_MLC) + (size_t)item * 2048 + d * 64 + e0;
    *(f32x4*)MLC = (f32x4){accv[0], accv[1], accv[2], accv[3]};
    *(f32x4*)(MLC + 4) = (f32x4){accv[4], accv[5], accv[6], accv[7]};
    if ((tid & 7) == 0) ((float*)(WS(p) + OFF_MLN))[(size_t)item * 32 + d] = nacc;
  }
  if (tid == 0) { float* ms = (float*)(WS(p) + OFF_MLS) + (size_t)item * 4; ms[0] = glast; ms[1] = amax; }
  __syncthreads();
}
__device__ __forceinline__ void ml_p2_item(const Params& p, int bh, unsigned* flag, char* ldsraw) {
  float* lds = (float*)ldsraw;
  const int tid = opaque_tid();
  float* MLS = (float*)(WS(p) + OFF_MLS) + (size_t)bh * 64 * 4;
  float* MLC = (float*)(WS(p) + OFF_MLC) + (size_t)bh * 64 * 2048;
  float* MLN = (float*)(WS(p) + OFF_MLN) + (size_t)bh * 64 * 32;
  if (tid == 0) {
    float m = 0.f;
    for (int c = 0; c < 64; c++) {
      const float gl = MLS[c * 4 + 0], am = MLS[c * 4 + 1];
      const float mn = fmaxf(gl + m, am);
      lds[c] = __expf(gl + m - mn); lds[64 + c] = __expf(am - mn);
      MLS[c * 4 + 2] = m;
      m = mn;
    }
  }
  __syncthreads();
  f32x4 C0 = {0.f, 0.f, 0.f, 0.f}, C1 = {0.f, 0.f, 0.f, 0.f}; float n = 0.f;
#pragma unroll 4
  for (int c = 0; c < 64; c++) {
    float* pc = MLC + (size_t)c * 2048 + tid * 8;
    const f32x4 l0 = *(const f32x4*)pc, l1 = *(const f32x4*)(pc + 4);
    float ln = 0.f; if (tid < 32) ln = MLN[c * 32 + tid];
    const float dec = lds[c], sc = lds[64 + c];
    *(f32x4*)pc = C0; *(f32x4*)(pc + 4) = C1; if (tid < 32) MLN[c * 32 + tid] = n;
    C0 = C0 * dec + l0 * sc; C1 = C1 * dec + l1 * sc; n = n * dec + ln * sc;
  }
  __threadfence();
  __syncthreads();
  if (tid == 0) { __hip_atomic_store(flag, 1u, __ATOMIC_RELEASE, __HIP_MEMORY_SCOPE_AGENT); }
  __syncthreads();
}
__device__ __forceinline__ void ml_p3_item(const Params& p, int l, int item, unsigned* flag, char* ldsraw) {
  if (flag) {
    if (opaque_tid() == 0) { unsigned sp = 0; while (__hip_atomic_load(flag, __ATOMIC_ACQUIRE, __HIP_MEMORY_SCOPE_AGENT) == 0u && ++sp < (1u << 24)) __builtin_amdgcn_s_sleep(2); }
    __syncthreads();
    __builtin_amdgcn_fence(__ATOMIC_ACQUIRE, "agent");
  }
  float* lds = (float*)ldsraw;
  float* Qs = lds;
  float* Ks = lds + 2112;
  float* Vs = lds + 4224;
  float* Cs = lds + 4224 + 4096;
  float* Ss = lds + 8320 + 2048;
  float* Ns = Ss + 64 * 65;
  float* Gs = Ns + 32;
  float* Bs = Gs + 64;
  float* Ms = Bs + 64;
  const bf16_t* P = (const bf16_t*)(WS(p) + OFF_P);
  bf16_t* Y = (bf16_t*)(WS(p) + OFF_Y);
  const int bh = item >> 6, c = item & 63, b = bh >> 2, h = bh & 3;
  const int tid = opaque_tid();
  const int tokb = b * S + c * 64;
  const float* cw = p.conv_w + l * 1024; const float* cb = p.conv_b + l * 256;
  const float mprev = ((const float*)(WS(p) + OFF_MLS))[(size_t)item * 4 + 2];
  {
    bf16_t* raw = (bf16_t*)(lds + 14784); float* wl = lds + 14784 + 2144;
    ml_stage_qk(P, cw, cb, raw, wl, tokb, c, h, tid);
#pragma unroll
    for (int i = 0; i < 2; i++) {
      const int ci = tid + 256 * i; const int row = ci >> 3, c8 = ci & 7;
      const u32x4 w = *(const u32x4*)(P + (size_t)(tokb + row) * PIN + C_ML + 256 + h * 64 + c8 * 8);
      *(f32x4*)(Vs + row * 64 + c8 * 8) = (f32x4){bflo(w[0]), bfhi(w[0]), bflo(w[1]), bfhi(w[1])};
      *(f32x4*)(Vs + row * 64 + c8 * 8 + 4) = (f32x4){bflo(w[2]), bfhi(w[2]), bflo(w[3]), bfhi(w[3])};
    }
    __syncthreads();
    const int t = tid >> 2, dq = tid & 3;
#pragma unroll
    for (int i = 0; i < 8; i++) {
      int d = dq * 8 + i;
      Qs[t * 33 + d] = ml_conv_lds(raw, wl, t, d) * 0.17677669529663687f;
      Ks[t * 33 + d] = ml_conv_lds(raw, wl, t, 32 + d);
    }
    const float* MLC = (const float*)(WS(p) + OFF_MLC) + (size_t)item * 2048;
    *(f32x4*)(Cs + tid * 8) = *(const f32x4*)(MLC + tid * 8); *(f32x4*)(Cs + tid * 8 + 4) = *(const f32x4*)(MLC + tid * 8 + 4);
    if (tid < 32) Ns[tid] = ((const float*)(WS(p) + OFF_MLN))[(size_t)item * 32 + tid];
  }
  if (tid < 64) {
    const int t = tid;
    const float ip = bf2f(P[(size_t)(tokb + t) * PIN + C_ML + 512 + h]) + p.i_bias[l * 4 + h];
    const float fp = bf2f(P[(size_t)(tokb + t) * PIN + C_ML + 516 + h]) + p.f_bias[l * 4 + h];
    const float lf = fminf(fp, 0.f) - log1pf(__expf(-fabsf(fp)));
    const float g = wave_scan_add_lds(Gs, t, lf);
    const float bb = ip - g;
    const float pm = wave_scan_max_lds(Ms, t, bb);
    Gs[t] = g; Bs[t] = bb; Ms[t] = fmaxf(g + mprev, g + pm);
  }
  __syncthreads();
  const int t = tid >> 2, eq = tid & 3;
  const float gt = Gs[t], mt = Ms[t];
  {
    float qv[32];
#pragma unroll
    for (int d = 0; d < 32; d++) qv[d] = Qs[t * 33 + d];
    for (int j = eq; j < 64; j += 4) {
      float sv = 0.f;
      if (j <= t) {
        float dot = 0.f;
#pragma unroll
        for (int d = 0; d < 32; d++) dot += qv[d] * Ks[j * 33 + d];
        sv = dot * __expf(gt + Bs[j] - mt);
      }
      Ss[t * 65 + j] = sv;
    }
  }
  __syncthreads();
  {
    const float iw = __expf(gt + mprev - mt);
    float num[16];
#pragma unroll
    for (int i = 0; i < 16; i++) num[i] = 0.f;
    float dn = 0.f;
    for (int d = 0; d < 32; d++) {
      const float qd = Qs[t * 33 + d];
      dn += qd * Ns[d];
#pragma unroll
      for (int i = 0; i < 16; i += 4) { const f32x4 cv = *(const f32x4*)(Cs + d * 64 + eq * 16 + i); num[i] += qd * cv[0]; num[i + 1] += qd * cv[1]; num[i + 2] += qd * cv[2]; num[i + 3] += qd * cv[3]; }
    }
    dn *= iw;
#pragma unroll
    for (int i = 0; i < 16; i++) num[i] *= iw;
    for (int j = 0; j <= t; j++) {
      const float sv = Ss[t * 65 + j];
      dn += sv;
#pragma unroll
      for (int i = 0; i < 16; i += 4) { const f32x4 vv = *(const f32x4*)(Vs + j * 64 + eq * 16 + i); num[i] += sv * vv[0]; num[i + 1] += sv * vv[1]; num[i + 2] += sv * vv[2]; num[i + 3] += sv * vv[3]; }
    }
    const float den = fmaxf(fabsf(dn), __expf(-mt));
    const float inv = 1.f / den;
    float ssq = 0.f;
#pragma unroll
    for (int i = 0; i < 16; i++) { num[i] *= inv; ssq += num[i] * num[i]; }
    ssq += __shfl_xor(ssq, 1); ssq += __shfl_xor(ssq, 2);
    const float rn = rsqrtf(ssq * (1.f / 64.f) + 1e-6f);
    const int tok = tokb + t;
    const float* on = p.ml_out_norm + l * 256 + h * 64 + eq * 16;
    const bf16_t* op = P + (size_t)tok * PIN + C_ML + 520 + h * 64 + eq * 16;
    bf16_t* yo = Y + (size_t)tok * 1024 + 768 + h * 64 + eq * 16;
#pragma unroll
    for (int i = 0; i < 16; i++) yo[i] = f2bf(num[i] * rn * on[i] * sigmoidf_(bf2f(op[i])));
  }
  __syncthreads();
}

__device__ __forceinline__ void attn_item(const Params& p, int l, int bh, int qt, char* lds) {
  const bf16_t* Q = (const bf16_t*)(WS(p) + OFF_Q); const bf16_t* KN = (const bf16_t*)(WS(p) + OFF_KN);
  const bf16_t* KPE = (const bf16_t*)(WS(p) + OFF_KPE); const bf16_t* VT = (const bf16_t*)(WS(p) + OFF_VT);
  bf16_t* Y = (bf16_t*)(WS(p) + OFF_Y);
  const int b = bh >> 2, h = bh & 3, q0 = qt * 128;
  const int tid = opaque_tid(), lane = tid & 63, wid = tid >> 6, fr = lane & 15, fq = lane >> 4;
  char* Ks = lds;
  char* Vs = lds + 49152;
  bf16x8 qf[2][6];
#pragma unroll
  for (int qs = 0; qs < 2; qs++)
#pragma unroll
    for (int kc = 0; kc < 6; kc++)
      qf[qs][kc] = *(const bf16x8*)(Q + (bh * S + q0 + wid * 32 + qs * 16 + fr) * 192 + kc * 32 + fq * 8);
  f32x4 o[2][8];
#pragma unroll
  for (int qs = 0; qs < 2; qs++)
#pragma unroll
    for (int nd = 0; nd < 8; nd++) o[qs][nd] = (f32x4){0.f, 0.f, 0.f, 0.f};
  float mrow[2] = {-1e30f, -1e30f}, lrow[2] = {0.f, 0.f};
  const int nkt = (q0 + 128) >> 6;
#define LDS3 __attribute__((address_space(3)))
  auto dmaK = [&](int kt, int bi) {
    int tt = tid; asm volatile("" : "+v"(tt));
    char* kb = Ks + bi * 24576;
#pragma unroll
    for (int i = 0; i < 6; i++) {
      const int g = i * 256 + tt; const int row = g / 24, cp = g - row * 24;
      const int c = (cp & ~7) | ((cp & 7) ^ ((row >> 1) & 7));
      const bf16_t* src_ = (c < 16) ? (KN + (bh * S + kt * 64 + row) * 128 + c * 8) : (KPE + (b * S + kt * 64 + row) * 64 + (c - 16) * 8);
      __builtin_amdgcn_global_load_lds((const unsigned*)src_, (LDS3 unsigned*)(kb + i * 4096 + tt * 16), 16, 0, 0);
    }
  };
  auto dmaV = [&](int kt) {
    int tt = tid; asm volatile("" : "+v"(tt));
#pragma unroll
    for (int i = 0; i < 4; i++) {
      const int g = i * 256 + tt; const int row = g >> 3, cp = g & 7; const int c = cp ^ ((row >> 1) & 7);
      __builtin_amdgcn_global_load_lds((const unsigned*)(VT + (bh * 128 + row) * S + kt * 64 + c * 8), (LDS3 unsigned*)(Vs + i * 4096 + tt * 16), 16, 0, 0);
    }
  };
  dmaK(0, 0); dmaV(0);
  asm volatile("s_waitcnt vmcnt(0)" ::: "memory"); __builtin_amdgcn_s_barrier(); asm volatile("" ::: "memory");
#pragma unroll 1
  for (int kt = 0; kt < nkt; kt++) {
    const bool more = (kt + 1 < nkt);
    const int k0 = kt * 64;
    const bool active = (k0 <= q0 + wid * 32 + 31);
    const char* kb = Ks + (kt & 1) * 24576;
    if (more) dmaK(kt + 1, (kt + 1) & 1);
    f32x4 sc[2][4];
    if (active) {
#pragma unroll
      for (int qs = 0; qs < 2; qs++)
#pragma unroll
        for (int ks = 0; ks < 4; ks++) sc[qs][ks] = (f32x4){0.f, 0.f, 0.f, 0.f};
#pragma unroll
      for (int ks = 0; ks < 4; ks++)
#pragma unroll
        for (int kc = 0; kc < 6; kc++) {
          const int krow_ = ks * 16 + fr, kcl_ = kc * 4 + fq;
          const bf16x8 kf = *(const bf16x8*)(kb + (krow_ * 24 + ((kcl_ & ~7) | ((kcl_ & 7) ^ ((krow_ >> 1) & 7)))) * 16);
          sc[0][ks] = __builtin_amdgcn_mfma_f32_16x16x32_bf16(kf, qf[0][kc], sc[0][ks], 0, 0, 0);
          sc[1][ks] = __builtin_amdgcn_mfma_f32_16x16x32_bf16(kf, qf[1][kc], sc[1][ks], 0, 0, 0);
          if (kc & 1) __builtin_amdgcn_sched_barrier(0);
        }
    }
    bf16x8 pf[2][2];
    if (active) {
      if (kt >= nkt - 2) {
#pragma unroll
        for (int qs = 0; qs < 2; qs++) {
          const int qrow = q0 + wid * 32 + qs * 16 + fr;
#pragma unroll
          for (int ks = 0; ks < 4; ks++)
#pragma unroll
            for (int j = 0; j < 4; j++) { const int key = k0 + ks * 16 + fq * 4 + j; if (key > qrow) sc[qs][ks][j] = -1e30f; }
        }
      }
#pragma unroll
      for (int qs = 0; qs < 2; qs++) {
        float mx = -1e30f;
#pragma unroll
        for (int ks = 0; ks < 4; ks++)
#pragma unroll
          for (int j = 0; j < 4; j++) mx = fmaxf(mx, sc[qs][ks][j]);
        mx = fmaxf(mx, __shfl_xor(mx, 16)); mx = fmaxf(mx, __shfl_xor(mx, 32));
        const float mn = fmaxf(mrow[qs], mx);
        const float alpha = __builtin_amdgcn_exp2f(mrow[qs] - mn);
        mrow[qs] = mn;
        float ps = 0.f;
#pragma unroll
        for (int ks = 0; ks < 4; ks++)
#pragma unroll
          for (int j = 0; j < 4; j++) { const float e = __builtin_amdgcn_exp2f(sc[qs][ks][j] - mn); sc[qs][ks][j] = e; ps += e; }
        lrow[qs] = lrow[qs] * alpha + ps;
#pragma unroll
        for (int nd = 0; nd < 8; nd++) o[qs][nd] *= alpha;
#pragma unroll
        for (int c2 = 0; c2 < 2; c2++) {
          u32x4 w;
          w[0] = pk2(sc[qs][2 * c2][0], sc[qs][2 * c2][1]); w[1] = pk2(sc[qs][2 * c2][2], sc[qs][2 * c2][3]);
          w[2] = pk2(sc[qs][2 * c2 + 1][0], sc[qs][2 * c2 + 1][1]); w[3] = pk2(sc[qs][2 * c2 + 1][2], sc[qs][2 * c2 + 1][3]);
          pf[qs][c2] = __builtin_bit_cast(bf16x8, w);
        }
      }
    }
    if (more) asm volatile("s_waitcnt vmcnt(6)" ::: "memory"); else asm volatile("s_waitcnt vmcnt(0)" ::: "memory");
    __builtin_amdgcn_s_barrier(); asm volatile("" ::: "memory");
    if (active) {
#pragma unroll
      for (int nd = 0; nd < 8; nd++)
#pragma unroll
        for (int c2 = 0; c2 < 2; c2++) {
          const int vrow_ = nd * 16 + fr;
          const bf16x8 vf = *(const bf16x8*)(Vs + (vrow_ * 8 + ((c2 * 4 + fq) ^ ((vrow_ >> 1) & 7))) * 16);
          o[0][nd] = __builtin_amdgcn_mfma_f32_16x16x32_bf16(vf, pf[0][c2], o[0][nd], 0, 0, 0);
          o[1][nd] = __builtin_amdgcn_mfma_f32_16x16x32_bf16(vf, pf[1][c2], o[1][nd], 0, 0, 0);
          if (c2 == 1) __builtin_amdgcn_sched_barrier(0);
        }
    }
    asm volatile("s_waitcnt vmcnt(0) lgkmcnt(0)" ::: "memory"); __builtin_amdgcn_s_barrier(); asm volatile("" ::: "memory");
    if (more) dmaV(kt + 1);
  }
  const float* on = p.mla_out_norm + l * 512 + h * 128;
#pragma unroll
  for (int qs = 0; qs < 2; qs++) {
    float lt = lrow[qs]; lt += __shfl_xor(lt, 16); lt += __shfl_xor(lt, 32);
    const float inv = 1.f / lt;
    float ssq = 0.f;
#pragma unroll
    for (int nd = 0; nd < 8; nd++) { o[qs][nd] *= inv; ssq += o[qs][nd][0] * o[qs][nd][0] + o[qs][nd][1] * o[qs][nd][1] + o[qs][nd][2] * o[qs][nd][2] + o[qs][nd][3] * o[qs][nd][3]; }
    ssq += __shfl_xor(ssq, 16); ssq += __shfl_xor(ssq, 32);
    const float rn = rsqrtf(ssq * (1.f / 128.f) + 1e-6f);
    const int tok = b * S + q0 + wid * 32 + qs * 16 + fr;
    bf16_t* yo = Y + (size_t)tok * 1024 + h * 128;
#pragma unroll
    for (int nd = 0; nd < 8; nd++) {
      const int dv = nd * 16 + fq * 4;
      const f32x4 g = *(const f32x4*)(on + dv);
      f32x4 v = o[qs][nd] * rn * g;
      u32x2 w; w[0] = pk2(v[0], v[1]); w[1] = pk2(v[2], v[3]);
      *(u32x2*)(yo + dv) = w;
    }
  }
}

__device__ __forceinline__ void final_norm_rows(const Params& p) {
  const int tid_ = opaque_tid(); const int lane = tid_ & 63, wid = tid_ >> 6;
  for (int row0 = (blockIdx.x * 4 + wid) * 4; row0 < T; row0 += gridDim.x * 16) {
    f32x4 v[4][4];
#pragma unroll
    for (int r = 0; r < 4; r++)
#pragma unroll
      for (int i = 0; i < 4; i++) v[r][i] = *(const f32x4*)(p.out + (size_t)(row0 + r) * DM + i * 256 + lane * 4);
#pragma unroll
    for (int r = 0; r < 4; r++) {
      float ss = 0.f;
#pragma unroll
      for (int i = 0; i < 4; i++) ss += v[r][i][0] * v[r][i][0] + v[r][i][1] * v[r][i][1] + v[r][i][2] * v[r][i][2] + v[r][i][3] * v[r][i][3];
      ss = wave_sum(ss);
      const float rn = rsqrtf(ss * (1.f / 1024.f) + 1e-6f);
#pragma unroll
      for (int i = 0; i < 4; i++) { const f32x4 g = *(const f32x4*)(p.final_norm + i * 256 + lane * 4); __builtin_nontemporal_store(v[r][i] * rn * g, (f32x4*)(p.out + (size_t)(row0 + r) * DM + i * 256 + lane * 4)); }
    }
  }
}

constexpr int N_PHASES = 16;
#ifndef ONLY
#define ONLY -1
#endif
#define EN(k) (ONLY < 0 || ONLY == (k))
__device__ __forceinline__ void run_phase(const Params& p, int ph, char* lds, int mode) {
  const int G = gridDim.x, B = blockIdx.x;
  if (ph == 0) {
    {
      const int tid = opaque_tid(), lane = tid & 63, wv = tid >> 6;
      bf16_t* xb = (bf16_t*)(WS(p) + OFF_XB); float* rss = (float*)(WS(p) + OFF_RSS);
      for (int row0 = (B * 4 + wv) * 4; row0 < T; row0 += G * 16) {
        f32x4 a[4][4];
#pragma unroll
        for (int r = 0; r < 4; r++)
#pragma unroll
          for (int i = 0; i < 4; i++) a[r][i] = __builtin_nontemporal_load((const f32x4*)(p.x + (size_t)(row0 + r) * DM + i * 256 + lane * 4));
#pragma unroll
        for (int r = 0; r < 4; r++) {
          float ss = 0.f;
#pragma unroll
          for (int i = 0; i < 4; i++) {
            u32x2 w; w[0] = pk2(a[r][i][0], a[r][i][1]); w[1] = pk2(a[r][i][2], a[r][i][3]);
            *(u32x2*)(xb + (size_t)(row0 + r) * DM + i * 256 + lane * 4) = w;
            const float b0 = bflo(w[0]), b1 = bfhi(w[0]), b2 = bflo(w[1]), b3 = bfhi(w[1]);
            ss += b0 * b0 + b1 * b1 + b2 * b2 + b3 * b3;
          }
          ss = wave_sum(ss);
          if (lane == 0) rss[row0 + r] = ss;
        }
      }
    }
    { float* z = (float*)(WS(p) + OFF_RSS) + 2 * T; for (int i = B * NTHREADS + opaque_tid(); i < 2 * T; i += G * NTHREADS) z[i] = 0.f; }
    for (int it = B; it < N_CONV_MIX; it += G) conv_mixer(p, 0, it, lds);
    return;
  }
  if (ph == 15) { final_norm_rows(p); return; }
  const int l = (ph - 1) / 7, sp = (ph - 1) % 7;
  const float* xin = (l == 0) ? p.x : p.out;
  switch (sp) {
    case 0: {
      float* z = (float*)(WS(p) + OFF_RSS) + T;
      for (int i = B * NTHREADS + opaque_tid(); i < T; i += G * NTHREADS) z[i] = 0.f;
      for (int it = B; it < 128 * 18; it += G) if (EN(1)) gemm_A(p, it, lds);
    } break;
    case 1: {
      if (l == 0) { float* z = (float*)(WS(p) + OFF_RSS); for (int i = B * NTHREADS + opaque_tid(); i < T; i += G * NTHREADS) z[i] = 0.f; }
      const int n = 768 + 1024 + 1024 + 1024;
      for (int it = B; it < n; it += G) {
        if (it < 768) { if (EN(10) && (mode == 0 || mode == 1)) gemm_Q(p, it, lds); }
        else if (it < 1792) { if (EN(11) && (mode == 0 || mode == 2)) gemm_KV(p, it - 768, lds); }
        else if (it < 2816) { if (EN(12) && (mode == 0 || mode == 3)) rwkv_prep_item(p, l, it - 1792, lds); }
        else { if (EN(13) && (mode == 0 || mode == 4)) ml_p1_item(p, l, it - 2816, lds); }
      }
    } break;
    case 2: {
      unsigned* ctr = (unsigned*)(WS(p) + OFF_CTRL) + (mode ? 8 + mode : l);
      int* sh = (int*)(lds + 74240);
      for (;;) {
        __syncthreads();
        if (opaque_tid() == 0) *sh = (int)atomicAdd(ctr, 1u);
        __syncthreads();
        int it = *sh;
        if (mode == 1) { if (it >= 192) break; }
        else if (mode == 2) { if (it >= 512) break; it += 208; }
        const int ntot = 192 + 16 + 512 + 1024 + N_CONV_FFN + (l == 0 ? N_CONV_MIX : 0);
        if (it >= ntot) break;
        unsigned* flags = (unsigned*)(WS(p) + OFF_CTRL) + 16 + l * 16;
        if (it < 192) { if (EN(20)) rwkv_scan2_item(p, it, lds); }
        else if (it < 208) { if (EN(21)) ml_p2_item(p, it - 192, flags + (it - 192), lds); }
        else if (it < 720) { const int a = it - 208; if (EN(22)) attn_item(p, l, a & 15, 31 - (a >> 4), lds); }
        else if (mode != 0) { }
        else if (it < 1744) { if (EN(30)) ml_p3_item(p, l, it - 720, flags + ((it - 720) >> 6), lds); }
        else if (it < 1744 + N_CONV_FFN) { if (EN(41)) conv_ffn(p, l, it - 1744, lds); }
        else conv_mixer(p, 1, it - 1744 - N_CONV_FFN, lds);
      }
    } break;
    case 3: for (int it = B; it < 1024; it += G) { if (EN(31)) rwkv_fin_item(p, l, it, lds); } break;
    case 4: {
      { float* z = (float*)(WS(p) + OFF_RSS) + 2 * T; for (int i = B * NTHREADS + opaque_tid(); i < 2 * T; i += G * NTHREADS) z[i] = 0.f; }
      const bf16_t* wo = (const bf16_t*)(WS(p) + ((l & 1) ? OFF_WOUT2 : OFF_WOUT));
      for (int it = B; it < 1024; it += G) { if (EN(40)) gemm_RES((const bf16_t*)(WS(p) + OFF_Y), 1024, wo, xin, p.out, (bf16_t*)(WS(p) + OFF_XB), (float*)(WS(p) + OFF_RSS) + T, it, lds); __syncthreads(); }
    } break;
    case 5: for (int it = B; it < 128 * 44; it += G) { if (mode == 1) gemm_GU_probe(p, it, lds); else if (EN(50)) gemm_GU(p, it, lds); } break;
    case 6: {
      for (int it = B; it < 1024; it += G) { if (EN(60)) gemm_RES((const bf16_t*)(WS(p) + OFF_U), DFF, (const bf16_t*)(WS(p) + OFF_WDN), p.out, p.out, (bf16_t*)(WS(p) + OFF_XB), (float*)(WS(p) + OFF_RSS), it, lds); __syncthreads(); }
    } break;
  }
}

__global__ void __launch_bounds__(NTHREADS, 2) mk_fwd(Params p) {
  extern __shared__ __attribute__((aligned(16))) char lds[];
  if (p.phase_hi > N_PHASES) cg::this_grid().sync();
  volatile LAS unsigned* st = (volatile LAS unsigned*)(lds + 74256);
  if (opaque_tid() == 0) { st[0] = 0u; st[1] = 0u; }
  __syncthreads();
  XcdBarrier xb = xcd_barrier_post((unsigned*)(WS(p) + OFF_BAR), st);
  const int nsteps = (p.phase_hi - p.phase_lo) + (PROBE_PH >= 0 ? 1 : 0);
  for (int i = 0; i < nsteps; i++) {
    int ph = p.phase_lo + i, mode = 0;
    if (PROBE_PH >= 0 && ph > PROBE_PH) { ph -= 1; if (ph == PROBE_PH) mode = PROBE_MODE; }
    if (i > 0) xcd_barrier(xb);
    run_phase(p, ph, lds, mode);
  }
}

extern "C" void kernel_launch(void* const* d_in, const int* in_sizes, int n_in, void* d_out, int out_size, void* d_ws, size_t ws_size, hipStream_t stream) {
  Params p{};
  p.x = (const float*)d_in[0]; p.pos = (const int*)d_in[1];
  p.mix_norm = (const float*)d_in[2]; p.w_in = (const float*)d_in[3]; p.q_norm = (const float*)d_in[4]; p.w_uq = (const float*)d_in[5];
  p.kv_norm = (const float*)d_in[6]; p.w_ukv = (const float*)d_in[7]; p.mla_out_norm = (const float*)d_in[8];
  p.mu = (const float*)d_in[9]; p.w0 = (const float*)d_in[10]; p.w2 = (const float*)d_in[11]; p.a0 = (const float*)d_in[12]; p.a2 = (const float*)d_in[13];
  p.g2 = (const float*)d_in[14]; p.k_k = (const float*)d_in[15]; p.k_a = (const float*)d_in[16]; p.r_k = (const float*)d_in[17];
  p.ln_w = (const float*)d_in[18]; p.ln_b = (const float*)d_in[19];
  p.conv_w = (const float*)d_in[20]; p.conv_b = (const float*)d_in[21]; p.i_bias = (const float*)d_in[22]; p.f_bias = (const float*)d_in[23]; p.ml_out_norm = (const float*)d_in[24];
  p.w_out = (const float*)d_in[25]; p.ffn_norm = (const float*)d_in[26]; p.w_gate = (const float*)d_in[27]; p.w_up = (const float*)d_in[28]; p.w_down = (const float*)d_in[29];
  p.final_norm = (const float*)d_in[30];
  p.out = (float*)d_out; p.ws = (unsigned char*)d_ws;
  static int grid_blocks = 0;
  if (!grid_blocks) {
    hipFuncSetAttribute((const void*)mk_fwd, hipFuncAttributeMaxDynamicSharedMemorySize, LDS_BYTES);
    int dev = 0, cus = 0, per_cu = 0;
    hipGetDevice(&dev);
    hipDeviceGetAttribute(&cus, hipDeviceAttributeMultiprocessorCount, dev);
    hipOccupancyMaxActiveBlocksPerMultiprocessor(&per_cu, mk_fwd, NTHREADS, LDS_BYTES);
    if (per_cu < 1) per_cu = 1;
    if (per_cu > 2) per_cu = 2;
    grid_blocks = cus * per_cu;
  }
  hipMemsetAsync(d_ws, 0, CTRL_BYTES, stream);
#if MK_ONE_LAUNCH
  p.phase_lo = 0; p.phase_hi = N_PHASES;
  void* args[] = {&p};
  hipError_t e = hipLaunchCooperativeKernel((const void*)mk_fwd, dim3(grid_blocks), dim3(NTHREADS), args, LDS_BYTES, stream);
  if (e != hipSuccess) fprintf(stderr, "cooperative launch failed: %s (grid %d)\n", hipGetErrorString(e), grid_blocks);
#else
  for (int ph = 0; ph < N_PHASES; ph++) {
    p.phase_lo = ph; p.phase_hi = ph + 1;
    hipLaunchKernelGGL(mk_fwd, dim3(grid_blocks), dim3(NTHREADS), LDS_BYTES, stream, p);
  }
#endif
}
```
